# Optimizing an MI355X kernel written in HIP

```python
import math
import jax, jax.numpy as jnp
from jax import lax
import numpy as np

D_MODEL = 1024
BATCH = 8
SEQ = 2048
DEPTH = 1
DEC_BATCH = 128
DEC_SEQ = 4
PAST_LEN = 8192
PAGE_SIZE = 128

N_META = 16
D_POOL = D_MODEL // 2
N_POOL_GROUPS = 4
POOL_GROUP_DIM = D_POOL // N_POOL_GROUPS
POOL_WINDOWS = (2, 4, 8, 16)
POOL_BUF = min(max(POOL_WINDOWS) - 1, PAST_LEN)
N_HEADS = 8
HEAD_DIM = 64
D_ATTN = N_HEADS * HEAD_DIM
N_KV_HEADS = 2
GROUP = N_HEADS // N_KV_HEADS
WINDOW = 128
BLOCK = 128
WIN_BUF = min(WINDOW, PAST_LEN)
REL_BUCKETS = 32
REL_MAX_DIST = 128
D_MIX = D_POOL + D_ATTN
D_KV = N_KV_HEADS * HEAD_DIM
D_IN_PROJ = D_POOL + D_ATTN + 2 * D_KV
D_FF = 4 * D_MODEL
ALPHA = (2.0 * DEPTH) ** 0.25
BETA = (8.0 * DEPTH) ** -0.25
LN_EPS = 1e-5

kernel_name = "hymba_pool_swa_sink_decoder_step"


def layer_norm(x, g, b):
    xf = x.astype(jnp.float32)
    mu = jnp.mean(xf, axis=-1, keepdims=True)
    var = jnp.mean(jnp.square(xf - mu), axis=-1, keepdims=True)
    return ((xf - mu) * lax.rsqrt(var + LN_EPS) * g.astype(jnp.float32) + b.astype(jnp.float32)).astype(x.dtype)


def split_in_proj(h, w_in):
    B, T = h.shape[:2]
    proj = jnp.einsum('btd,de->bte', h, w_in)
    u, q, k, v = jnp.split(proj, [D_POOL, D_POOL + D_ATTN, D_POOL + D_ATTN + D_KV], axis=-1)
    return (u, q.reshape(B, T, N_HEADS, HEAD_DIM),
            k.reshape(B, T, N_KV_HEADS, HEAD_DIM), v.reshape(B, T, N_KV_HEADS, HEAD_DIM))


def pool_mix(u, pos, w_pool, scale):
    T = u.shape[1]
    c = jnp.cumsum(u.astype(jnp.float32), axis=1)
    c = jnp.concatenate([jnp.zeros_like(c[:, :1]), c], axis=1)
    idx = jnp.arange(T)
    outs = []
    for g, w in enumerate(POOL_WINDOWS):
        cg = c[:, :, g * POOL_GROUP_DIM:(g + 1) * POOL_GROUP_DIM]
        lo = jnp.maximum(idx + 1 - w, 0)
        s = cg[:, 1:] - jnp.take(cg, lo, axis=1)
        cnt = jnp.minimum(w, pos + 1).astype(jnp.float32)[None, :, None]
        ug = u[:, :, g * POOL_GROUP_DIM:(g + 1) * POOL_GROUP_DIM].astype(jnp.float32)
        outs.append(s / cnt - ug)
    p = jnp.stack(outs, axis=2).astype(u.dtype)
    z = jnp.einsum('btgc,gcd->btgd', p, w_pool)
    return z.reshape(u.shape) * scale


def rel_bias(dist, table):
    n = jnp.maximum(dist, 0)
    max_exact = REL_BUCKETS // 2
    nf = jnp.maximum(n, 1).astype(jnp.float32)
    large = max_exact + (jnp.log(nf / max_exact) / math.log(REL_MAX_DIST / max_exact)
                         * (REL_BUCKETS - max_exact)).astype(jnp.int32)
    large = jnp.minimum(large, REL_BUCKETS - 1)
    bucket = jnp.where(n < max_exact, n, large)
    return jnp.moveaxis(table[bucket].astype(jnp.float32), -1, 0)


def sink_attend(q, k, v, bias, mask, sinks):
    s = jnp.einsum('bnqhgd,bnkhd->bnhgqk', q, k, preferred_element_type=jnp.float32) * (HEAD_DIM ** -0.5)
    s = s + bias.reshape(N_KV_HEADS, GROUP, bias.shape[1], bias.shape[2])
    s = jnp.where(mask[None, :, None, None], s, -jnp.inf)
    sink = sinks.astype(jnp.float32).reshape(1, 1, N_KV_HEADS, GROUP, 1, 1)
    m = jnp.maximum(jnp.max(s, axis=-1, keepdims=True), sink)
    p = jnp.exp(s - m)
    p = p / (jnp.sum(p, axis=-1, keepdims=True) + jnp.exp(sink - m))
    return jnp.einsum('bnhgqk,bnkhd->bnqhgd', p.astype(v.dtype), v)


def prompt_attention(q, k, v, table, sinks):
    B, L = q.shape[:2]
    pad = BLOCK - N_META
    Lp = L + pad
    nb = Lp // BLOCK

    def padf(t):
        return jnp.pad(t, ((0, 0), (pad, 0)) + ((0, 0),) * (t.ndim - 2))

    def prev(t):
        return jnp.concatenate([jnp.zeros_like(t[:, :1]), t[:, :-1]], axis=1)

    qb = padf(q).reshape(B, nb, BLOCK, N_KV_HEADS, GROUP, HEAD_DIM)
    kb = padf(k).reshape(B, nb, BLOCK, N_KV_HEADS, HEAD_DIM)
    vb = padf(v).reshape(B, nb, BLOCK, N_KV_HEADS, HEAD_DIM)
    kk = jnp.concatenate([prev(kb), kb], axis=2)
    vv = jnp.concatenate([prev(vb), vb], axis=2)
    dist = (jnp.arange(BLOCK)[:, None] + BLOCK) - jnp.arange(2 * BLOCK)[None, :]
    key_pos = (jnp.arange(nb)[:, None] * BLOCK - BLOCK + jnp.arange(2 * BLOCK)[None, :]) - pad
    mask = ((dist >= 0) & (dist < WINDOW))[None] & (key_pos >= 0)[:, None, :]
    o = sink_attend(qb, kk, vv, rel_bias(dist, table), mask, sinks)
    return o.reshape(B, Lp, D_ATTN)[:, pad:]


def sample_attention(q, k, v, k_cache, v_cache, table, sinks):
    DB, T = q.shape[:2]
    kk = jnp.concatenate([k_cache, k], axis=1)
    vv = jnp.concatenate([v_cache, v], axis=1)
    dist = (jnp.arange(T)[:, None] + WIN_BUF) - jnp.arange(WIN_BUF + T)[None, :]
    mask = ((dist >= 0) & (dist < WINDOW))[None]
    o = sink_attend(q.reshape(DB, 1, T, N_KV_HEADS, GROUP, HEAD_DIM), kk[:, None], vv[:, None],
                    rel_bias(dist, table), mask, sinks)
    return o.reshape(DB, T, D_ATTN), kk[:, -WIN_BUF:], vv[:, -WIN_BUF:]


def finish_layer(h, z_pool, o_attn, w_out, ln1_g, ln1_b, w_mlp_in, w_mlp_out, ln2_g, ln2_b):
    mix = jnp.einsum('bte,ed->btd', jnp.concatenate([z_pool, o_attn], axis=-1), w_out)
    h = layer_norm(ALPHA * h + mix, ln1_g, ln1_b)
    f = jnp.einsum('btf,fd->btd', jnp.square(jax.nn.relu(jnp.einsum('btd,df->btf', h, w_mlp_in))), w_mlp_out)
    return layer_norm(ALPHA * h + f, ln2_g, ln2_b)


def setup_inputs(seed: int = 0) -> dict:
    key = jax.random.key(seed)
    ks = jax.random.split(key, 24)

    def nrm(k, shape, s=1.0):
        return jax.random.normal(k, shape, jnp.float32) * s

    return {
        "x_prompt": nrm(ks[0], (BATCH, SEQ, D_MODEL)),
        "x_sample": nrm(ks[1], (DEC_BATCH, DEC_SEQ, D_MODEL)),
        "cache_win_k": nrm(ks[2], (DEPTH, DEC_BATCH, WIN_BUF, N_KV_HEADS, HEAD_DIM)),
        "cache_win_v": nrm(ks[3], (DEPTH, DEC_BATCH, WIN_BUF, N_KV_HEADS, HEAD_DIM)),
        "state_pool": nrm(ks[4], (DEPTH, DEC_BATCH, POOL_BUF, D_POOL)),
        "meta_tokens": nrm(ks[5], (N_META, D_MODEL)),
        "ln_emb_g": 1.0 + nrm(ks[6], (D_MODEL,), 0.1),
        "ln_emb_b": nrm(ks[7], (D_MODEL,), 0.02),
        "rel_table": nrm(ks[8], (REL_BUCKETS, N_HEADS), 0.5),
        "w_in": nrm(ks[9], (DEPTH, D_MODEL, D_IN_PROJ), D_MODEL ** -0.5),
        "w_pool": nrm(ks[10], (DEPTH, N_POOL_GROUPS, POOL_GROUP_DIM, POOL_GROUP_DIM), POOL_GROUP_DIM ** -0.5),
        "pool_scale": 1.0 + nrm(ks[11], (DEPTH, D_POOL), 0.1),
        "sinks": nrm(ks[12], (DEPTH, N_HEADS), 0.5),
        "w_out": nrm(ks[13], (DEPTH, D_MIX, D_MODEL), BETA * D_MIX ** -0.5),
        "ln1_g": 1.0 + nrm(ks[14], (DEPTH, D_MODEL), 0.1),
        "ln1_b": nrm(ks[15], (DEPTH, D_MODEL), 0.02),
        "w_mlp_in": nrm(ks[16], (DEPTH, D_MODEL, D_FF), D_MODEL ** -0.5),
        "w_mlp_out": nrm(ks[17], (DEPTH, D_FF, D_MODEL), BETA * D_FF ** -0.5),
        "ln2_g": 1.0 + nrm(ks[18], (DEPTH, D_MODEL), 0.1),
        "ln2_b": nrm(ks[19], (DEPTH, D_MODEL), 0.02),
    }


def reference(x_prompt, x_sample, cache_win_k, cache_win_v, state_pool, meta_tokens, ln_emb_g, ln_emb_b,
              rel_table, w_in, w_pool, pool_scale, sinks, w_out, ln1_g, ln1_b, w_mlp_in, w_mlp_out,
              ln2_g, ln2_b):
    B = x_prompt.shape[0]
    meta = jnp.broadcast_to(meta_tokens[None].astype(x_prompt.dtype), (B, N_META, D_MODEL))
    hp = layer_norm(jnp.concatenate([meta, x_prompt], axis=1), ln_emb_g, ln_emb_b)
    hs = layer_norm(x_sample, ln_emb_g, ln_emb_b)
    T = hs.shape[1]
    pos_p = jnp.arange(hp.shape[1])
    pos_s = PAST_LEN - POOL_BUF + jnp.arange(POOL_BUF + T)

    nk_p, nv_p, np_p, nk_s, nv_s, np_s = [], [], [], [], [], []
    for l in range(DEPTH):
        u, q, k, v = split_in_proj(hp, w_in[l])
        z_p = pool_mix(u, pos_p, w_pool[l], pool_scale[l])
        o_p = prompt_attention(q, k, v, rel_table, sinks[l])
        nk_p.append(k[:, -WIN_BUF:])
        nv_p.append(v[:, -WIN_BUF:])
        np_p.append(u[:, -POOL_BUF:])
        hp = finish_layer(hp, z_p, o_p, w_out[l], ln1_g[l], ln1_b[l], w_mlp_in[l], w_mlp_out[l], ln2_g[l], ln2_b[l])
        u, q, k, v = split_in_proj(hs, w_in[l])
        u_ext = jnp.concatenate([state_pool[l].astype(u.dtype), u], axis=1)
        z_s = pool_mix(u_ext, pos_s, w_pool[l], pool_scale[l])[:, POOL_BUF:]
        o_s, k_buf, v_buf = sample_attention(q, k, v, cache_win_k[l].astype(k.dtype), cache_win_v[l].astype(v.dtype),
                                             rel_table, sinks[l])
        nk_s.append(k_buf)
        nv_s.append(v_buf)
        np_s.append(u_ext[:, -POOL_BUF:])
        hs = finish_layer(hs, z_s, o_s, w_out[l], ln1_g[l], ln1_b[l], w_mlp_in[l], w_mlp_out[l], ln2_g[l], ln2_b[l])

    y_prompt = hp[:, N_META:]
    return (y_prompt, hs, jnp.stack(nk_p), jnp.stack(nv_p), jnp.stack(np_p),
            jnp.stack(nk_s), jnp.stack(nv_s), jnp.stack(np_s))
```

```cpp
#include <hip/hip_runtime.h>
#include <cstdio>
#include <cstdint>

namespace nv {
constexpr int D = 1024, BATCH = 8, SEQ = 2048, NMETA = 16, L = SEQ + NMETA;
constexpr int DB = 128, DSEQ = 4, NPR = BATCH * L  , NSR = DB * DSEQ  , M = NPR + NSR  ;
constexpr int DPOOL = 512, NH = 8, HD = 64, NKV = 2, WIN = 128, PBUF = 15;
constexpr int DIN = 1280, DFF = 4096;
constexpr int QOFF = 512, KOFF = 1024, VOFF = 1152;
constexpr float ALPHA = 1.189207115002721f, LN_EPS = 1e-5f;
constexpr size_t O_YP = 0, O_YS = 16777216, O_KP = 17301504, O_VP = 17432576, O_PP = 17563648, O_KS = 17625088, O_VS = 19722240, O_PS = 21819392;

__device__ __forceinline__ float block_sum256(float v, float* sh) {
    for (int o = 32; o > 0; o >>= 1) v += __shfl_xor(v, o);
    __syncthreads();
    if ((threadIdx.x & 63) == 0) sh[threadIdx.x >> 6] = v;
    __syncthreads();
    return sh[0] + sh[1] + sh[2] + sh[3];
}
__device__ __forceinline__ void ln_row(const float* src, float* dst, const float* g, const float* b, float* sh) {
    float v[4]; float s = 0.f;
    for (int j = 0; j < 4; ++j) { v[j] = src[threadIdx.x + 256 * j]; s += v[j]; }
    const float mean = block_sum256(s, sh) * (1.f / D);
    float q = 0.f;
    for (int j = 0; j < 4; ++j) { v[j] -= mean; q += v[j] * v[j]; }
    const float rstd = rsqrtf(block_sum256(q, sh) * (1.f / D) + LN_EPS);
    for (int j = 0; j < 4; ++j) { const int c = threadIdx.x + 256 * j; dst[c] = v[j] * rstd * g[c] + b[c]; }
}
__global__ void k_ln_emb(const float* xp, const float* xs, const float* meta, const float* g, const float* b, float* h0) {
    __shared__ float sh[4];
    const int m = blockIdx.x; const float* src;
    if (m < NPR) { const int bb = m / L, t = m % L; src = t < NMETA ? meta + (size_t)t * D : xp + ((size_t)bb * SEQ + (t - NMETA)) * D; }
    else src = xs + (size_t)(m - NPR) * D;
    ln_row(src, h0 + (size_t)m * D, g, b, sh);
}
__global__ void k_ln_rows(float* buf, const float* g, const float* b) {
    __shared__ float sh[4];
    ln_row(buf + (size_t)blockIdx.x * D, buf + (size_t)blockIdx.x * D, g, b, sh);
}
__global__ void k_ln_out(const float* r2, int m0, const float* g, const float* b, float* out) {
    __shared__ float sh[4];
    const int m = m0 + blockIdx.x; float* dst;
    if (m < NPR) { const int bb = m / L, t = m % L; if (t < NMETA) return; dst = out + O_YP + ((size_t)bb * SEQ + (t - NMETA)) * D; }
    else dst = out + O_YS + (size_t)(m - NPR) * D;
    ln_row(r2 + (size_t)blockIdx.x * D, dst, g, b, sh);
}
template <int EPI>
__global__ void k_gemm(const float* A, int lda, const float* B, int ldb, float* C, int ldc, int K, const float* R, int ldr) {
    __shared__ float As[16][64 + 4], Bs[16][64];
    const int tx = threadIdx.x & 15, ty = threadIdx.x >> 4, m0 = blockIdx.y * 64, n0 = blockIdx.x * 64;
    float acc[4][4] = {};
    for (int k0 = 0; k0 < K; k0 += 16) {
        for (int i = threadIdx.x; i < 64 * 16; i += 256) { const int r = i >> 4, c = i & 15; As[c][r] = A[(size_t)(m0 + r) * lda + k0 + c]; }
        for (int i = threadIdx.x; i < 16 * 64; i += 256) { const int r = i >> 6, c = i & 63; Bs[r][c] = B[(size_t)(k0 + r) * ldb + n0 + c]; }
        __syncthreads();
#pragma unroll
        for (int k = 0; k < 16; ++k) {
            float a[4], bv[4];
#pragma unroll
            for (int i = 0; i < 4; ++i) { a[i] = As[k][ty * 4 + i]; bv[i] = Bs[k][tx * 4 + i]; }
#pragma unroll
            for (int i = 0; i < 4; ++i)
#pragma unroll
                for (int j = 0; j < 4; ++j) acc[i][j] += a[i] * bv[j];
        }
        __syncthreads();
    }
    for (int i = 0; i < 4; ++i)
        for (int j = 0; j < 4; ++j) {
            const int m = m0 + ty * 4 + i, n = n0 + tx * 4 + j; float v = acc[i][j];
            if (EPI == 1) v += ALPHA * R[(size_t)m * ldr + n];
            if (EPI == 2) { v = v > 0.f ? v : 0.f; v = v * v; }
            if (EPI == 3) v *= R[n];
            C[(size_t)m * ldc + n] = v;
        }
}
__global__ void k_pool_p(const float* proj, const float* state_pool, float* p) {
    const int m = blockIdx.x;
    for (int c = threadIdx.x; c < DPOOL; c += 256) {
        const int g = c >> 7, w = 2 << g;
        float s = 0.f, cnt;
        if (m < NPR) { const int t = m % L; const int n = (t + 1) < w ? (t + 1) : w; cnt = (float)n;
            for (int i = 0; i < n; ++i) s += proj[(size_t)(m - i) * DIN + c]; }
        else { const int r = m - NPR, db = r >> 2, sx = r & 3; cnt = (float)w;
            for (int i = 0; i < w; ++i) { const int idx = PBUF + sx - i;
                s += idx >= PBUF ? proj[(size_t)(NPR + db * 4 + (idx - PBUF)) * DIN + c] : state_pool[((size_t)db * PBUF + idx) * DPOOL + c]; } }
        p[(size_t)m * DPOOL + c] = s / cnt - proj[(size_t)m * DIN + c];
    }
}
__device__ __forceinline__ int rel_bucket(int n) {
    if (n < 16) return n;
    int l = 16 + (int)(logf((float)n / 16.f) / 2.0794415416798357f * 16.f);
    return l < 31 ? l : 31;
}
__global__ void k_attn(const float* proj, const float* ck, const float* cv, const float* rel, const float* sinks, float* mix) {
    __shared__ float sq[64], sp[128], red[2];
    const int m = blockIdx.x, h = blockIdx.y, hk = h >> 2, j = threadIdx.x;
    if (j < 64) sq[j] = proj[(size_t)m * DIN + QOFF + h * HD + j];
    __syncthreads();
    const float* kp = nullptr; const float* vp = nullptr; bool valid;
    if (m < NPR) { const int t = m % L; valid = (t - j) >= 0;
        if (valid) { kp = proj + (size_t)(m - j) * DIN + KOFF + hk * HD; vp = proj + (size_t)(m - j) * DIN + VOFF + hk * HD; } }
    else { const int r = m - NPR, db = r >> 2, sx = r & 3; const int idx = sx + WIN - j;
        valid = true;
        if (idx >= WIN) { const size_t row = NPR + db * 4 + (idx - WIN); kp = proj + row * DIN + KOFF + hk * HD; vp = proj + row * DIN + VOFF + hk * HD; }
        else { kp = ck + (((size_t)db * WIN + idx) * NKV + hk) * HD; vp = cv + (((size_t)db * WIN + idx) * NKV + hk) * HD; } }
    float s = -INFINITY;
    if (valid) { float a = 0.f;
#pragma unroll 8
        for (int d = 0; d < HD; ++d) a += sq[d] * kp[d]; s = a * 0.125f + rel[rel_bucket(j) * NH + h]; }
    float mx = s; for (int o = 32; o > 0; o >>= 1) mx = fmaxf(mx, __shfl_xor(mx, o));
    if ((j & 63) == 0) red[j >> 6] = mx;
    __syncthreads();
    const float sink = sinks[h]; mx = fmaxf(fmaxf(red[0], red[1]), sink);
    const float pe = valid ? expf(s - mx) : 0.f;
    sp[j] = pe;
    float sum = pe; for (int o = 32; o > 0; o >>= 1) sum += __shfl_xor(sum, o);
    __syncthreads();
    if ((j & 63) == 0) red[j >> 6] = sum;
    __syncthreads();
    const float den = red[0] + red[1] + expf(sink - mx);
    if (j < 64) {
        float o = 0.f;
#pragma unroll 2
        for (int jj = 0; jj < 128; ++jj) {
            const float* v2;
            if (m < NPR) { const int t = m % L; if (t - jj < 0) continue; v2 = proj + (size_t)(m - jj) * DIN + VOFF + hk * HD; }
            else { const int r = m - NPR, db = r >> 2, sx = r & 3; const int idx = sx + WIN - jj;
                v2 = idx >= WIN ? proj + (size_t)(NPR + db * 4 + (idx - WIN)) * DIN + VOFF + hk * HD : cv + (((size_t)db * WIN + idx) * NKV + hk) * HD; }
            o += sp[jj] * v2[j];
        }
        mix[(size_t)m * D + DPOOL + h * HD + j] = o / den;
    }
}
__global__ void k_caches(const float* proj, const float* ck, const float* cv, const float* sp, float* out) {
    const size_t i = (size_t)blockIdx.x * 256 + threadIdx.x;
    if (i < 131072) { const int b = i / (128 * 128), r = (i / 128) % 128, c = i % 128; const size_t row = (size_t)b * L + (L - WIN) + r;
        out[O_KP + i] = proj[row * DIN + KOFF + c]; out[O_VP + i] = proj[row * DIN + VOFF + c]; }
    if (i < 61440) { const int b = i / (15 * 512), r = (i / 512) % 15, c = i % 512; const size_t row = (size_t)b * L + (L - PBUF) + r;
        out[O_PP + i] = proj[row * DIN + c]; }
    if (i < 2097152) { const int db = i / (128 * 128), r = (i / 128) % 128, c = i % 128;
        const int idx = r + 4;
        out[O_KS + i] = idx < WIN ? ck[((size_t)db * WIN + idx) * 128 + c] : proj[(size_t)(NPR + db * 4 + idx - WIN) * DIN + KOFF + c];
        out[O_VS + i] = idx < WIN ? cv[((size_t)db * WIN + idx) * 128 + c] : proj[(size_t)(NPR + db * 4 + idx - WIN) * DIN + VOFF + c]; }
    if (i < 983040) { const int db = i / (15 * 512), r = (i / 512) % 15, c = i % 512; const int idx = r + 4;
        out[O_PS + i] = idx < PBUF ? sp[((size_t)db * PBUF + idx) * DPOOL + c] : proj[(size_t)(NPR + db * 4 + idx - PBUF) * DIN + c]; }
}
}

extern "C" void kernel_launch(void* const* d_in, const int* in_sizes, int n_in, void* d_out, int out_size, void* d_ws, size_t ws_size, hipStream_t stream) {
    using namespace nv;
    const float* xp = (const float*)d_in[0]; const float* xs = (const float*)d_in[1]; const float* ck = (const float*)d_in[2]; const float* cv = (const float*)d_in[3];
    const float* spool = (const float*)d_in[4]; const float* meta = (const float*)d_in[5]; const float* eg = (const float*)d_in[6]; const float* eb = (const float*)d_in[7];
    const float* rel = (const float*)d_in[8]; const float* w_in = (const float*)d_in[9]; const float* w_pool = (const float*)d_in[10]; const float* pscale = (const float*)d_in[11];
    const float* sinks = (const float*)d_in[12]; const float* w_out = (const float*)d_in[13]; const float* g1 = (const float*)d_in[14]; const float* b1 = (const float*)d_in[15];
    const float* w1 = (const float*)d_in[16]; const float* w2 = (const float*)d_in[17]; const float* g2 = (const float*)d_in[18]; const float* b2 = (const float*)d_in[19];
    float* out = (float*)d_out; float* ws = (float*)d_ws;
    float* h0 = ws;
    float* proj = h0 + (size_t)M * D;
    float* h1 = proj + (size_t)M * DIN;
    float* p = h1;
    float* mix = out;
    float* act = ws;
    k_ln_emb<<<M, 256, 0, stream>>>(xp, xs, meta, eg, eb, h0);
    k_gemm<0><<<dim3(DIN / 64, M / 64), 256, 0, stream>>>(h0, D, w_in, DIN, proj, DIN, D, nullptr, 0);
    k_pool_p<<<M, 256, 0, stream>>>(proj, spool, p);
    for (int g = 0; g < 4; ++g)
        k_gemm<3><<<dim3(2, M / 64), 256, 0, stream>>>(p + g * 128, DPOOL, w_pool + (size_t)g * 128 * 128, 128, mix + g * 128, D, 128, pscale + g * 128, 0);
    k_attn<<<dim3(M, NH), 128, 0, stream>>>(proj, ck, cv, rel, sinks, mix);
    k_gemm<1><<<dim3(D / 64, M / 64), 256, 0, stream>>>(mix, D, w_out, D, h1, D, D, h0, D);
    k_ln_rows<<<M, 256, 0, stream>>>(h1, g1, b1);
    k_caches<<<(2097152 + 255) / 256, 256, 0, stream>>>(proj, ck, cv, spool, out);
    constexpr int CH = 2432;
    float* r2 = act + (size_t)CH * DFF;
    for (int c0 = 0; c0 < M; c0 += CH) {
        k_gemm<2><<<dim3(DFF / 64, CH / 64), 256, 0, stream>>>(h1 + (size_t)c0 * D, D, w1, DFF, act, DFF, D, nullptr, 0);
        k_gemm<1><<<dim3(D / 64, CH / 64), 256, 0, stream>>>(act, DFF, w2, D, r2, D, DFF, h1 + (size_t)c0 * D, D);
        k_ln_out<<<CH, 256, 0, stream>>>(r2, c0, g2, b2, out);
    }
}
```

```cpp
#include <hip/hip_runtime.h>
#include <cstdio>
#include <cstdint>
namespace pg8 {
#define PG8_LAS __attribute__((address_space(3)))
typedef unsigned short bf16_t;
typedef short bf16x8 __attribute__((ext_vector_type(8)));
typedef float f32x4 __attribute__((ext_vector_type(4)));
typedef unsigned u32x4 __attribute__((ext_vector_type(4)));
constexpr int BM = 256, BK = 64, HALF = 128, HTB = HALF * BK * 2  , STAGE_BYTES = 8 * HTB, NXCD = 8, WGM = 8;

__host__ __device__ __forceinline__ int lds_byte(int r, int c) { const int st = (r >> 4) * 2 + (c >> 5), rr = r & 15, cc = c & 31, ob = rr * 64 + cc * 2; return st * 1024 + (ob ^ (((ob >> 9) & 1) << 5)); }
__host__ __device__ __forceinline__ void stage_rc(int b, int& R, int& C) { const int st = b / 1024, sb = b % 1024, swz = sb ^ (((sb >> 9) & 1) << 5); R = (st >> 1) * 16 + swz / 64; C = (st & 1) * 32 + (swz % 64) / 2; }
__host__ __device__ __forceinline__ int perm32(int rho) { const int n = rho >> 4, i = rho & 15; return 8 * (i >> 2) + 4 * n + (i & 3); }

struct Unit { int pm, pn; };
struct Gemm { const bf16_t* A; const bf16_t* Bt; int M, N, K; };

struct StaticOrder {
    int nM, nN, nwg, G, c;
    __host__ __device__ void init(int M, int N, int G_, int c_) { nM = M / BM; nN = N / BM; nwg = nM * nN; G = G_; c = c_; }
    __host__ __device__ bool next(int i, Unit& u) const {
        const long L = (long)i * G + c; if (L >= nwg) return false;
        int wgid = (int)L; { const int q = nwg / NXCD, r = nwg % NXCD, xcd = wgid % NXCD, off = wgid / NXCD; wgid = (xcd < r ? xcd * (q + 1) : r * (q + 1) + (xcd - r) * q) + off; }
        const int nig = WGM * nN, gid = wgid / nig, fm = gid * WGM, gsz = (nM - fm) < WGM ? (nM - fm) : WGM;
        u.pm = fm + ((wgid % nig) % gsz); u.pn = (wgid % nig) / gsz; return true;
    }
    __device__ __forceinline__ void a_ready(const Unit&) const {}
    __device__ __forceinline__ void done(const Unit&) const {}
};

__device__ __forceinline__ unsigned cvt_pk_bf16(float lo, float hi) { unsigned r; asm volatile("v_cvt_pk_bf16_f32 %0, %1, %2" : "=v"(r) : "v"(lo), "v"(hi)); return r; }
typedef float f32x2 __attribute__((ext_vector_type(2)));
typedef unsigned u32x2 __attribute__((ext_vector_type(2)));
constexpr float kAlpha = 1.189207115002721f;
__device__ __forceinline__ float bf_lo(unsigned x) { return __uint_as_float(x << 16); }
__device__ __forceinline__ float bf_hi(unsigned x) { return __uint_as_float(x & 0xffff0000u); }
template <int MODE> struct EpiB {
    static constexpr bool PERM = true, AFTER_DRAIN = false;
    bf16_t* O; int ldc; const bf16_t* res; int ldr;
    __device__ __forceinline__ void operator()(const f32x4 (&acc)[2][2][4][2], const Unit& u, int wr, int wc, int fr, int fq) const {
        const int row0 = u.pm * BM + wr * 64 + fr, col0 = u.pn * BM + wc * 32 + 8 * fq;
#pragma unroll
        for (int ai = 0; ai < 2; ++ai)
#pragma unroll
            for (int m = 0; m < 4; ++m) { const size_t row = (size_t)(row0 + ai * HALF + m * 16); bf16_t* rowp = O + row * ldc + col0;
#pragma unroll
                for (int bj = 0; bj < 2; ++bj) { f32x4 v0 = acc[ai][bj][m][0], v1 = acc[ai][bj][m][1];
                    if (MODE == 1) {
#pragma unroll
                        for (int e = 0; e < 4; ++e) { const float a = v0[e] > 0.f ? v0[e] : 0.f, b = v1[e] > 0.f ? v1[e] : 0.f; v0[e] = a * a; v1[e] = b * b; } }
                    if (MODE == 2) { const u32x4 rv = *(const u32x4*)(res + row * ldr + col0 + bj * HALF);
                        v0[0] += kAlpha * bf_lo(rv.x); v0[1] += kAlpha * bf_hi(rv.x); v0[2] += kAlpha * bf_lo(rv.y); v0[3] += kAlpha * bf_hi(rv.y);
                        v1[0] += kAlpha * bf_lo(rv.z); v1[1] += kAlpha * bf_hi(rv.z); v1[2] += kAlpha * bf_lo(rv.w); v1[3] += kAlpha * bf_hi(rv.w); }
                    u32x4 w; w.x = cvt_pk_bf16(v0[0], v0[1]); w.y = cvt_pk_bf16(v0[2], v0[3]); w.z = cvt_pk_bf16(v1[0], v1[1]); w.w = cvt_pk_bf16(v1[2], v1[3]);
                    *(u32x4*)(rowp + bj * HALF) = w; } }
    }
};
struct EpiOut {
    static constexpr bool PERM = false, AFTER_DRAIN = false;
    float* out; const bf16_t* res;
    static __device__ __forceinline__ float* out_row(float* out, int row) {
        if (row < 16512) { const int b = row / 2064, t = row - b * 2064; return t < 16 ? nullptr : out + ((size_t)b * 2048 + (t - 16)) * 1024; }
        if (row < 17024) return out + 16777216 + (size_t)(row - 16512) * 1024;
        return nullptr;
    }
    __device__ __forceinline__ void operator()(const f32x4 (&acc)[2][2][4][2], const Unit& u, int wr, int wc, int fr, int fq) const {
        const int row0 = u.pm * BM + wr * 64 + fr, col0 = u.pn * BM + wc * 32 + 4 * fq;
#pragma unroll
        for (int ai = 0; ai < 2; ++ai)
#pragma unroll
            for (int m = 0; m < 4; ++m) { const int row = row0 + ai * HALF + m * 16; float* op = out_row(out, row);
                if (op) {
#pragma unroll
                    for (int bj = 0; bj < 2; ++bj)
#pragma unroll
                        for (int n = 0; n < 2; ++n) { const int col = col0 + bj * HALF + n * 16; const u32x2 rv = *(const u32x2*)(res + (size_t)row * 1024 + col); f32x4 v = acc[ai][bj][m][n];
                            v[0] += kAlpha * bf_lo(rv.x); v[1] += kAlpha * bf_hi(rv.x); v[2] += kAlpha * bf_lo(rv.y); v[3] += kAlpha * bf_hi(rv.y);
                            *(f32x4*)(op + col) = v; } } }
    }
};

template <class Epi, class Sched, bool ALIGN_EPI = false, bool SP2 = false>
__device__ __forceinline__ void gemm_phase(PG8_LAS unsigned char* lds, const Gemm g, const Sched& S, const Epi& E) {
    const int tid = threadIdx.x, wid = __builtin_amdgcn_readfirstlane(tid >> 6), lane = tid & 63, wr = wid >> 2, wc = wid & 3, fr = lane & 15, fq = lane >> 4;
    const int K = g.K, nt = K / BK;
    unsigned voffA[2], voffB[2];
#pragma unroll
    for (int i = 0; i < 2; ++i) { int R, C; stage_rc(tid * 16 + i * 8192, R, C); const int Rb = Epi::PERM ? ((R & ~31) + perm32(R & 31)) : R;
        voffA[i] = (unsigned)(R * K + C) * 2u; voffB[i] = (unsigned)(Rb * K + C) * 2u; }
    const size_t kstep = (size_t)(BK * 2);
    const size_t hstep = (size_t)HALF * K * 2;
    const size_t tstep = 2 * hstep;
    const unsigned ldsw = (unsigned)wid * 1024u;
    const int aoff = lds_byte(wr * 64 + fr, fq * 8), boff = lds_byte(wc * 32 + fr, fq * 8);
#define PG8_SA(b, h) (((b) * 2 + (h)) * HTB)
#define PG8_SB(b, h) ((4 + (b) * 2 + (h)) * HTB)
#define PG8_STAGE(bufoff, gbase, voff) do { _Pragma("unroll") for (int _i = 0; _i < 2; ++_i) \
        __builtin_amdgcn_global_load_lds((const unsigned*)((const char*)(gbase) + (voff)[_i]), (PG8_LAS unsigned*)(lds + (bufoff) + ldsw + _i * 8192), 16, 0, 0); } while (0)
#define PG8_LDA(dst, b, h) do { _Pragma("unroll") for (int m = 0; m < 4; ++m) _Pragma("unroll") for (int k = 0; k < 2; ++k) dst[m][k] = *(const PG8_LAS bf16x8*)(lds + PG8_SA(b, h) + aoff + m * 2048 + k * 1024); } while (0)
#define PG8_LDB(dst, b, h) do { _Pragma("unroll") for (int n = 0; n < 2; ++n) _Pragma("unroll") for (int k = 0; k < 2; ++k) dst[n][k] = *(const PG8_LAS bf16x8*)(lds + PG8_SB(b, h) + boff + n * 2048 + k * 1024); } while (0)
#define PG8_MMA(ai, bj, At, Bt) do { __builtin_amdgcn_s_setprio(1); _Pragma("unroll") for (int m = 0; m < 4; ++m) _Pragma("unroll") for (int n = 0; n < 2; ++n) _Pragma("unroll") for (int k = 0; k < 2; ++k) \
        acc[ai][bj][m][n] = __builtin_amdgcn_mfma_f32_16x16x32_bf16(Bt[n][k], At[m][k], acc[ai][bj][m][n], 0, 0, 0); __builtin_amdgcn_s_setprio(0); } while (0)
#define PG8_WAIT_V(n) asm volatile("s_waitcnt vmcnt(" #n ")" ::: "memory")
#define PG8_WAIT_L(n) asm volatile("s_waitcnt lgkmcnt(" #n ")" ::: "memory")
#define PG8_BAR __builtin_amdgcn_s_barrier()
#define PG8_SCHED __builtin_amdgcn_sched_barrier(0)
    Unit cur, nxt; int ui = 0;
    if (!S.next(0, cur)) return;
    f32x4 acc[2][2][4][2];
#pragma unroll
    for (int a = 0; a < 2; ++a)
#pragma unroll
        for (int b = 0; b < 2; ++b)
#pragma unroll
            for (int m = 0; m < 4; ++m)
#pragma unroll
                for (int n = 0; n < 2; ++n) acc[a][b][m][n] = (f32x4){0.f, 0.f, 0.f, 0.f};
    bf16x8 At[4][2], B0[2][2], B1[2][2];
    const char* cA = (const char*)g.A + (size_t)cur.pm * tstep; const char* cB = (const char*)g.Bt + (size_t)cur.pn * tstep;
    S.a_ready(cur);
    if constexpr (SP2) {
        PG8_STAGE(PG8_SB(0, 0), cB, voffB); PG8_STAGE(PG8_SB(0, 1), cB + hstep, voffB); PG8_STAGE(PG8_SA(0, 0), cA, voffA); PG8_STAGE(PG8_SA(0, 1), cA + hstep, voffA);
        if (wr == 1) PG8_BAR;
        PG8_WAIT_V(2); PG8_BAR;
        PG8_STAGE(PG8_SB(1, 0), cB + kstep, voffB); PG8_STAGE(PG8_SA(1, 0), cA + kstep, voffA); PG8_STAGE(PG8_SB(1, 1), cB + hstep + kstep, voffB);
        PG8_WAIT_V(6); PG8_BAR;
    } else {
        PG8_STAGE(PG8_SB(0, 0), cB, voffB); PG8_STAGE(PG8_SA(0, 0), cA, voffA); PG8_STAGE(PG8_SB(0, 1), cB + hstep, voffB); PG8_STAGE(PG8_SA(0, 1), cA + hstep, voffA);
        if (wr == 1) PG8_BAR;
        PG8_WAIT_V(4); PG8_BAR;
        PG8_STAGE(PG8_SB(1, 0), cB + kstep, voffB); PG8_STAGE(PG8_SA(1, 0), cA + kstep, voffA); PG8_STAGE(PG8_SB(1, 1), cB + hstep + kstep, voffB);
        PG8_WAIT_V(6); PG8_BAR;
    }
    for (;;) {
        const bool has_next = S.next(ui + 1, nxt);
        const char* nA = has_next ? (const char*)g.A + (size_t)nxt.pm * tstep : cA; const char* nB = has_next ? (const char*)g.Bt + (size_t)nxt.pn * tstep : cB;
        for (int t = 0; t < nt; t += 2) {
            const bool last = (t == nt - 2);
            const char* a1 = cA + (size_t)(t + 1) * kstep;
            const char* a2 = last ? nA : cA + (size_t)(t + 2) * kstep; const char* b2 = last ? nB : cB + (size_t)(t + 2) * kstep;
            const char* a3 = a2 + kstep; const char* b3 = b2 + kstep;
            if (last && has_next) S.a_ready(nxt);
            if constexpr (SP2) {
            PG8_LDB(B0, 0, 0); PG8_LDB(B1, 0, 1); PG8_SCHED; PG8_LDA(At, 0, 0); PG8_STAGE(PG8_SA(1, 1), a1 + hstep, voffA);
            PG8_WAIT_V(8); PG8_WAIT_L(0); PG8_BAR; PG8_MMA(0, 0, At, B0); PG8_MMA(0, 1, At, B1); PG8_BAR; PG8_SCHED;
            PG8_LDA(At, 0, 1); PG8_STAGE(PG8_SB(0, 0), b2, voffB); PG8_STAGE(PG8_SB(0, 1), b2 + hstep, voffB); PG8_STAGE(PG8_SA(0, 0), a2, voffA);
            PG8_WAIT_V(8); PG8_WAIT_L(0); PG8_BAR; PG8_MMA(1, 0, At, B0); PG8_MMA(1, 1, At, B1); PG8_BAR; PG8_SCHED;
            PG8_LDB(B0, 1, 0); PG8_LDB(B1, 1, 1); PG8_SCHED; PG8_LDA(At, 1, 0); PG8_STAGE(PG8_SA(0, 1), a2 + hstep, voffA);
            PG8_WAIT_V(8); PG8_WAIT_L(0); PG8_BAR; PG8_MMA(0, 0, At, B0); PG8_MMA(0, 1, At, B1); PG8_BAR; PG8_SCHED;
            PG8_LDA(At, 1, 1); PG8_STAGE(PG8_SB(1, 0), b3, voffB); PG8_STAGE(PG8_SB(1, 1), b3 + hstep, voffB); PG8_STAGE(PG8_SA(1, 0), a3, voffA);
            PG8_WAIT_V(8); PG8_WAIT_L(0); PG8_BAR; PG8_MMA(1, 0, At, B0); PG8_MMA(1, 1, At, B1); PG8_BAR; PG8_SCHED;
            } else {
            PG8_LDB(B0, 0, 0); PG8_SCHED; PG8_LDA(At, 0, 0); PG8_STAGE(PG8_SA(1, 1), a1 + hstep, voffA);
            PG8_WAIT_L(8); PG8_BAR; PG8_WAIT_L(0); PG8_MMA(0, 0, At, B0); PG8_BAR; PG8_SCHED;
            PG8_LDB(B1, 0, 1); PG8_STAGE(PG8_SB(0, 0), b2, voffB);
            PG8_BAR; PG8_WAIT_L(0); PG8_MMA(0, 1, At, B1); PG8_BAR;
            PG8_LDA(At, 0, 1); PG8_STAGE(PG8_SA(0, 0), a2, voffA);
            PG8_BAR; PG8_WAIT_L(0); PG8_MMA(1, 0, At, B0); PG8_BAR; PG8_SCHED;
            PG8_STAGE(PG8_SB(0, 1), b2 + hstep, voffB);
            PG8_WAIT_V(6); PG8_BAR; PG8_MMA(1, 1, At, B1); PG8_BAR;
            PG8_LDB(B0, 1, 0); PG8_SCHED; PG8_LDA(At, 1, 0); PG8_STAGE(PG8_SA(0, 1), a2 + hstep, voffA);
            PG8_WAIT_L(8); PG8_BAR; PG8_WAIT_L(0); PG8_MMA(0, 0, At, B0); PG8_BAR; PG8_SCHED;
            PG8_LDB(B1, 1, 1); PG8_STAGE(PG8_SB(1, 0), b3, voffB);
            PG8_BAR; PG8_WAIT_L(0); PG8_MMA(0, 1, At, B1); PG8_BAR;
            PG8_LDA(At, 1, 1); PG8_STAGE(PG8_SA(1, 0), a3, voffA);
            PG8_BAR; PG8_WAIT_L(0); PG8_MMA(1, 0, At, B0); PG8_BAR; PG8_SCHED;
            PG8_STAGE(PG8_SB(1, 1), b3 + hstep, voffB);
            PG8_WAIT_V(6); PG8_BAR; PG8_MMA(1, 1, At, B1); PG8_BAR;
            }
        }
        if constexpr (ALIGN_EPI) { if (wr == 0) PG8_BAR; }
        if constexpr (!Epi::AFTER_DRAIN) { E(acc, cur, wr, wc, fr, fq); S.done(cur); }
        if (!has_next) break;
#pragma unroll
        for (int a = 0; a < 2; ++a)
#pragma unroll
            for (int b = 0; b < 2; ++b)
#pragma unroll
                for (int m = 0; m < 4; ++m)
#pragma unroll
                    for (int n = 0; n < 2; ++n) acc[a][b][m][n] = (f32x4){0.f, 0.f, 0.f, 0.f};
        cur = nxt; cA = nA; cB = nB; ++ui;
        if constexpr (ALIGN_EPI) { if (wr == 1) PG8_BAR; }
    }
    PG8_WAIT_V(0);
    if constexpr (!ALIGN_EPI) { if (wr == 0) PG8_BAR; }
    PG8_BAR;
    if constexpr (Epi::AFTER_DRAIN) { E.fused(acc, cur, wr, wc, fr, fq, lds, wid, lane); S.done(cur); }
#undef PG8_SA
#undef PG8_SB
#undef PG8_STAGE
#undef PG8_LDA
#undef PG8_LDB
#undef PG8_MMA
#undef PG8_WAIT_V
#undef PG8_WAIT_L
#undef PG8_BAR
#undef PG8_SCHED
}
}
#define GAS __attribute__((address_space(1)))
#define LAS __attribute__((address_space(3)))
typedef unsigned short bf16;
typedef unsigned v4u __attribute__((ext_vector_type(4)));
typedef float f32x4 __attribute__((ext_vector_type(4)));
typedef short bf16x8 __attribute__((ext_vector_type(8)));
typedef GAS unsigned gu32;
typedef GAS unsigned long long gu64;
#define RLX_AGENT __ATOMIC_RELAXED, __HIP_MEMORY_SCOPE_AGENT
#define LDS_WAIT() asm volatile("s_waitcnt lgkmcnt(0)" ::: "memory")
#define VM_WAIT() asm volatile("s_waitcnt vmcnt(0)" ::: "memory")
__device__ __forceinline__ unsigned long long rt() { return __builtin_amdgcn_s_memrealtime(); }
__device__ __forceinline__ unsigned f2bf(float f) { unsigned u = __builtin_bit_cast(unsigned, f); return (u + 0x7fffu + ((u >> 16) & 1u)) >> 16; }
__device__ __forceinline__ unsigned pk2(float lo, float hi) { return f2bf(lo) | (f2bf(hi) << 16); }
#define XB_TMO      128
#define XB_XCNT(j)  (256  + 64 * (j))
#define XB_XSUB(j)  (1280 + 64 * (j))
#define XB_XGEN(j)  (2304 + 64 * (j))
#define XB_TOP      3328
#define XB_TOPGEN   3392
#define XCD_BAR_WORDS 3456
#define XB_SPIN_CAP (1u << 18)

__device__ __forceinline__ unsigned xb_ld(unsigned* p)              { return __hip_atomic_load(p, __ATOMIC_RELAXED, __HIP_MEMORY_SCOPE_AGENT); }
__device__ __forceinline__ unsigned xb_add(unsigned* p, unsigned v) { return __hip_atomic_fetch_add(p, v, __ATOMIC_RELAXED, __HIP_MEMORY_SCOPE_AGENT); }
__device__ __forceinline__ unsigned xb_xcc_id() { return (unsigned)__builtin_amdgcn_s_getreg((3 << 11) | 20) & 0xFu; }
#define XB_SPIN(cond, bar) do { unsigned _sp = 0; while (cond) { __builtin_amdgcn_s_sleep(1); \
    if ((++_sp & 255u) == 0u) { if (xb_ld(&(bar)[XB_TMO])) break; if (_sp > XB_SPIN_CAP) { atomicAdd(&(bar)[XB_TMO], 1u); break; } } } } while (0)

struct XcdBarrier {
    unsigned* bar; unsigned x;
    volatile LAS unsigned* st;
};

__device__ __forceinline__ XcdBarrier xcd_barrier_post(unsigned* bar, volatile LAS unsigned* st) {
    XcdBarrier b; b.bar = bar; b.x = xb_xcc_id(); b.st = st;
    if (threadIdx.x == 0) (void)xb_add(&bar[XB_XCNT(b.x)], 1u);
    return b;
}
__device__ __forceinline__ void xcd_barrier_complete(unsigned* bar, unsigned x, unsigned& nloc, unsigned& nx) {
    const unsigned G = gridDim.x * gridDim.y * gridDim.z;
    unsigned sum, cnt, mine, sp = 0u;
    for (;;) {
        sum = 0u; cnt = 0u; mine = 0u;
#pragma unroll
        for (unsigned j = 0; j < 16; ++j) { const unsigned c = xb_ld(&bar[XB_XCNT(j)]); sum += c; cnt += (c > 0u) ? 1u : 0u; mine = (j == x) ? c : mine; }
        if (sum == G) break;
        __builtin_amdgcn_s_sleep(1);
        if ((++sp & 255u) == 0u) { if (xb_ld(&bar[XB_TMO])) break; if (sp > XB_SPIN_CAP) { atomicAdd(&bar[XB_TMO], 1u); break; } }
    }
    nloc = mine > 0u ? mine : 1u; nx = cnt > 0u ? cnt : 1u;
}

__device__ __forceinline__ void xcd_barrier(const XcdBarrier& b) {
    asm volatile("s_waitcnt vmcnt(0)" ::: "memory");
    __syncthreads();
    if (threadIdx.x == 0) {
        unsigned* bar = b.bar;
        __builtin_amdgcn_s_waitcnt(0);
        unsigned nloc = b.st[0], nx = b.st[1];
        if (nloc == 0u) { xcd_barrier_complete(bar, b.x, nloc, nx); b.st[0] = nloc; b.st[1] = nx; }
        const unsigned old = xb_add(&bar[XB_XSUB(b.x)], 1u);
        const unsigned gen = old / nloc;
        if (old + 1u == (gen + 1u) * nloc) {
            __builtin_amdgcn_fence(__ATOMIC_RELEASE, "agent");
            asm volatile("s_waitcnt vmcnt(0)" ::: "memory");
            const unsigned og = xb_add(&bar[XB_TOP], 1u);
            const unsigned tg = og / nx;
            if (og + 1u == (tg + 1u) * nx) xb_add(&bar[XB_TOPGEN], 1u);
            else XB_SPIN(xb_ld(&bar[XB_TOPGEN]) == tg, bar);
            __builtin_amdgcn_fence(__ATOMIC_ACQUIRE, "agent");
            xb_add(&bar[XB_XGEN(b.x)], 1u);
            asm volatile("s_waitcnt vmcnt(0)" ::: "memory");
        } else {
            XB_SPIN(xb_ld(&bar[XB_XGEN(b.x)]) == gen, bar);
            __builtin_amdgcn_fence(__ATOMIC_ACQUIRE, "agent");
            asm volatile("s_waitcnt vmcnt(0)" ::: "memory");
        }
    }
    __syncthreads();
}

constexpr int NWAVES = 8;
#ifndef MK_N_LAUNCHES
#define MK_N_LAUNCHES 1
#endif
constexpr int N_PHASES = 8;
constexpr int N_LAUNCHES = MK_N_LAUNCHES;
constexpr int D = 1024, LSEQ = 2064  , NPR = 8 * LSEQ  , NSR = 512  , M = NPR + NSR  , MP = 17152  ;
constexpr int DIN = 1280, DFF = 4096, DPOOL = 512, QOFF = 512, KOFF = 1024, VOFF = 1152;
constexpr float LN_EPS = 1e-5f, LOG2E = 1.4426950408889634f;
constexpr size_t O_YP = 0, O_YS = 16777216, O_KP = 17301504, O_VP = 17432576, O_PP = 17563648, O_KS = 17625088, O_VS = 19722240, O_PS = 21819392;
constexpr size_t MiB = 1u << 20;
constexpr size_t WS_CTL = 0, CTL_ZERO_BYTES = 1 * MiB;
constexpr size_t WS_WIN = 1 * MiB, WS_WOUT = 4 * MiB, WS_W1 = 6 * MiB, WS_W2 = 14 * MiB, WS_WPOOL = 22 * MiB;
constexpr size_t WS_R1 = 23 * MiB, WS_H1 = 57 * MiB;
constexpr size_t WS_H0 = 91 * MiB, WS_PROJ = 125 * MiB, WS_MIX = 167 * MiB;
constexpr size_t WS_ACT = 91 * MiB;
constexpr size_t WS_END = 225 * MiB;
static_assert(WS_WIN + (size_t)DIN * D * 2 <= WS_WOUT && WS_WPOOL + 4 * 128 * 128 * 2 <= WS_R1 && WS_R1 + (size_t)MP * D * 2 <= WS_H1 && WS_H1 + (size_t)MP * D * 2 <= WS_H0 &&
              WS_H0 + (size_t)MP * D * 2 <= WS_PROJ && WS_PROJ + (size_t)MP * DIN * 2 <= WS_MIX && WS_MIX + (size_t)MP * D * 2 <= WS_END && WS_ACT + (size_t)MP * DFF * 2 <= WS_END, "d_ws map");
constexpr int CW_BAR = 4096;
constexpr int RING_BYTES = 131072;
constexpr int LDSCTL_OFF = RING_BYTES, MISC_OFF = LDSCTL_OFF + 320;
constexpr int LDS_BYTES = 147456;
constexpr int TAB_OFF = 65536;

struct Frame {
    LAS unsigned char* lds;
    volatile LAS unsigned* MISC;
    gu32* ctl;
    int tid, lane, wave, vcu, G;
    const float *xp, *xs, *ck, *cv, *spool, *meta, *eg, *eb, *rel, *w_in, *w_pool, *pscale, *sinks, *w_out, *g1, *b1, *w1, *w2, *g2, *b2;
    float* out;
    bf16 *WIN_T, *WOUT_T, *W1_T, *W2_T, *WPOOL_T, *R1, *H1, *H0, *PROJ, *MIX, *ACT;
};

__device__ __forceinline__ float wave_sum(float v) {
#pragma unroll
    for (int o = 1; o < 64; o <<= 1) v += __shfl_xor(v, o);
    return v;
}
__device__ __forceinline__ void p0_transpose_item(const float* W, int K, int N, bf16* WT, LAS float* scr, int item, int lane) {
    const int nblk = N / 32, kb = item / nblk, nb = item % nblk, k0 = 64 * kb, n0 = 32 * nb;
#pragma unroll 8
    for (int i = 0; i < 32; ++i) { const int kk = 2 * i + (lane >> 5); scr[kk * 33 + (lane & 31)] = W[(size_t)(k0 + kk) * N + n0 + (lane & 31)]; }
    LDS_WAIT(); asm volatile("" ::: "memory");
    const int c = lane & 7;
#pragma unroll
    for (int j = 0; j < 4; ++j) { const int n = (lane >> 3) + 8 * j; const LAS float* s = scr + (8 * c) * 33 + n;
        v4u o; o.x = pk2(s[0 * 33], s[1 * 33]); o.y = pk2(s[2 * 33], s[3 * 33]); o.z = pk2(s[4 * 33], s[5 * 33]); o.w = pk2(s[6 * 33], s[7 * 33]);
        *(GAS v4u*)(WT + (size_t)(n0 + n) * K + k0 + 8 * c) = o; }
    LDS_WAIT(); asm volatile("" ::: "memory");
}
__device__ __forceinline__ void ln_f32row_to_bf16(const float* xrow, bf16* orow, const float* g, const float* b, int lane) {
    const GAS f32x4* xr = (const GAS f32x4*)xrow + lane;
    f32x4 v[4]; float s = 0.f;
#pragma unroll
    for (int j = 0; j < 4; ++j) { v[j] = xr[64 * j]; s += (v[j].x + v[j].y) + (v[j].z + v[j].w); }
    const float mean = wave_sum(s) * (1.f / D); float s2 = 0.f;
#pragma unroll
    for (int j = 0; j < 4; ++j) { v[j] = v[j] - mean; s2 += (v[j].x * v[j].x + v[j].y * v[j].y) + (v[j].z * v[j].z + v[j].w * v[j].w); }
    const float rstd = 1.f / sqrtf(wave_sum(s2) * (1.f / D) + LN_EPS);
    GAS unsigned long long* o8 = (GAS unsigned long long*)orow + lane;
#pragma unroll
    for (int j = 0; j < 4; ++j) { const f32x4 gv = ((const GAS f32x4*)g)[lane + 64 * j], bv = ((const GAS f32x4*)b)[lane + 64 * j]; const f32x4 o = v[j] * rstd * gv + bv;
        o8[64 * j] = (unsigned long long)pk2(o.x, o.y) | ((unsigned long long)pk2(o.z, o.w) << 32); }
}
__device__ __forceinline__ void ln_bf16row_to_bf16(const bf16* xrow, bf16* orow, const float* g, const float* b, int lane) {
    float x[16]; float s = 0.f;
#pragma unroll
    for (int jj = 0; jj < 2; ++jj) { const v4u w = ((const GAS v4u*)xrow)[lane + 64 * jj];
        x[8 * jj + 0] = pg8::bf_lo(w.x); x[8 * jj + 1] = pg8::bf_hi(w.x); x[8 * jj + 2] = pg8::bf_lo(w.y); x[8 * jj + 3] = pg8::bf_hi(w.y);
        x[8 * jj + 4] = pg8::bf_lo(w.z); x[8 * jj + 5] = pg8::bf_hi(w.z); x[8 * jj + 6] = pg8::bf_lo(w.w); x[8 * jj + 7] = pg8::bf_hi(w.w); }
#pragma unroll
    for (int e = 0; e < 16; ++e) s += x[e];
    const float mean = wave_sum(s) * (1.f / D); float s2 = 0.f;
#pragma unroll
    for (int e = 0; e < 16; ++e) { x[e] -= mean; s2 += x[e] * x[e]; }
    const float rstd = 1.f / sqrtf(wave_sum(s2) * (1.f / D) + LN_EPS);
#pragma unroll
    for (int jj = 0; jj < 2; ++jj) { const int base = 512 * jj + 8 * lane;
        const f32x4 g0 = *(const GAS f32x4*)(g + base), g1v = *(const GAS f32x4*)(g + base + 4), b0 = *(const GAS f32x4*)(b + base), b1v = *(const GAS f32x4*)(b + base + 4);
        v4u o; o.x = pk2(x[8 * jj + 0] * rstd * g0.x + b0.x, x[8 * jj + 1] * rstd * g0.y + b0.y); o.y = pk2(x[8 * jj + 2] * rstd * g0.z + b0.z, x[8 * jj + 3] * rstd * g0.w + b0.w);
        o.z = pk2(x[8 * jj + 4] * rstd * g1v.x + b1v.x, x[8 * jj + 5] * rstd * g1v.y + b1v.y); o.w = pk2(x[8 * jj + 6] * rstd * g1v.z + b1v.z, x[8 * jj + 7] * rstd * g1v.w + b1v.w);
        ((GAS v4u*)orow)[lane + 64 * jj] = o; }
}
__device__ __forceinline__ void ln_f32row_inplace(float* row, const float* g, const float* b, int lane) {
    GAS f32x4* xr = (GAS f32x4*)row + lane;
    f32x4 v[4]; float s = 0.f;
#pragma unroll
    for (int j = 0; j < 4; ++j) { v[j] = xr[64 * j]; s += (v[j].x + v[j].y) + (v[j].z + v[j].w); }
    const float mean = wave_sum(s) * (1.f / D); float s2 = 0.f;
#pragma unroll
    for (int j = 0; j < 4; ++j) { v[j] = v[j] - mean; s2 += (v[j].x * v[j].x + v[j].y * v[j].y) + (v[j].z * v[j].z + v[j].w * v[j].w); }
    const float rstd = 1.f / sqrtf(wave_sum(s2) * (1.f / D) + LN_EPS);
#pragma unroll
    for (int j = 0; j < 4; ++j) { const f32x4 gv = ((const GAS f32x4*)g)[lane + 64 * j], bv = ((const GAS f32x4*)b)[lane + 64 * j]; xr[64 * j] = v[j] * rstd * gv + bv; }
}

__device__ __forceinline__ void p0_prologue(Frame& F) {
    LAS float* scr = (LAS float*)(F.lds + F.wave * 16384);
    const int gw = F.vcu * NWAVES + F.wave, NGW = F.G * NWAVES;
    constexpr int I_IN = (D / 64) * (DIN / 32), I_OUT = (D / 64) * (D / 32), I_1 = (D / 64) * (DFF / 32), I_2 = (DFF / 64) * (D / 32), I_P = (128 / 64) * (128 / 32);
    constexpr int NITEMS = I_IN + I_OUT + I_1 + I_2 + 4 * I_P;
    for (int it = gw; it < NITEMS; it += NGW) {
        int r = it;
        if (r < I_1) { p0_transpose_item(F.w1, D, DFF, F.W1_T, scr, r, F.lane); continue; } r -= I_1;
        if (r < I_2) { p0_transpose_item(F.w2, DFF, D, F.W2_T, scr, r, F.lane); continue; } r -= I_2;
        if (r < I_IN) { p0_transpose_item(F.w_in, D, DIN, F.WIN_T, scr, r, F.lane); continue; } r -= I_IN;
        if (r < I_OUT) { p0_transpose_item(F.w_out, D, D, F.WOUT_T, scr, r, F.lane); continue; } r -= I_OUT;
        { const int g = r / I_P; p0_transpose_item(F.w_pool + (size_t)g * 128 * 128, 128, 128, F.WPOOL_T + (size_t)g * 128 * 128, scr, r % I_P, F.lane); }
    }
    for (int m = gw; m < MP; m += NGW) {
        bf16* orow = F.H0 + (size_t)m * D;
        if (m < M) { const float* src;
            if (m < NPR) { const int b = m / LSEQ, t = m - b * LSEQ; src = t < 16 ? F.meta + (size_t)t * D : F.xp + ((size_t)b * 2048 + (t - 16)) * D; }
            else src = F.xs + (size_t)(m - NPR) * D;
            ln_f32row_to_bf16(src, orow, F.eg, F.eb, F.lane); }
        else { const v4u z = {0u, 0u, 0u, 0u}; ((GAS v4u*)orow)[F.lane] = z; ((GAS v4u*)orow)[F.lane + 64] = z; ((GAS v4u*)(F.MIX + (size_t)m * D))[F.lane] = z; ((GAS v4u*)(F.MIX + (size_t)m * D))[F.lane + 64] = z; }
    }
    const int gt = gw * 64 + F.lane, NGT = NGW * 64;
    constexpr int NKV4 = 128 * 124 * 128 / 4, NP4 = 128 * 11 * 512 / 4;
    for (int i = gt; i < 2 * NKV4 + NP4; i += NGT) {
        if (i < 2 * NKV4) { const int which = i >= NKV4, j = which ? i - NKV4 : i; const int db = j / (124 * 32), rem = j - db * (124 * 32);
            const float* src = (which ? F.cv : F.ck) + (size_t)db * 128 * 128 + 4 * 128 + (size_t)rem * 4; float* dst = F.out + (which ? O_VS : O_KS) + (size_t)db * 128 * 128 + (size_t)rem * 4;
            *(GAS f32x4*)dst = *(const GAS f32x4*)src; }
        else { const int j = i - 2 * NKV4; const int db = j / (11 * 128), rem = j - db * (11 * 128);
            *(GAS f32x4*)(F.out + O_PS + (size_t)db * 15 * 512 + (size_t)rem * 4) = *(const GAS f32x4*)(F.spool + (size_t)db * 15 * 512 + 4 * 512 + (size_t)rem * 4); }
    }
}

namespace mixer {
typedef short bf16x8 __attribute__((ext_vector_type(8)));
typedef short s16x4 __attribute__((ext_vector_type(4)));
typedef float f32x16 __attribute__((ext_vector_type(16)));
typedef unsigned u32x2 __attribute__((ext_vector_type(2)));
typedef float f32x2_t __attribute__((ext_vector_type(2))); typedef __bf16 bf16x2_t __attribute__((ext_vector_type(2)));
typedef short v4i16_t __attribute__((ext_vector_type(4)));
__device__ __forceinline__ unsigned cvtpk(float lo, float hi) { f32x2_t v = {lo, hi}; bf16x2_t b = __builtin_convertvector(v, bf16x2_t); return __builtin_bit_cast(unsigned, b); }
__device__ __forceinline__ float bflo(unsigned x) { return __uint_as_float(x << 16); }
__device__ __forceinline__ float bfhi(unsigned x) { return __uint_as_float(x & 0xffff0000u); }
__device__ __forceinline__ bf16x8 ldcvt8(const float* p) { const f32x4 a = *(const GAS f32x4*)p, b = *(const GAS f32x4*)(p + 4);
    v4u w; w.x = cvtpk(a.x, a.y); w.y = cvtpk(a.z, a.w); w.z = cvtpk(b.x, b.y); w.w = cvtpk(b.z, b.w); return __builtin_bit_cast(bf16x8, w); }
__device__ __forceinline__ s16x4 vtr(const LAS unsigned char* p) { return __builtin_bit_cast(s16x4, __builtin_amdgcn_ds_read_tr16_b64_v4i16((LAS v4i16_t*)p)); }
__device__ __forceinline__ float swapmax(float m) { auto rr = __builtin_amdgcn_permlane32_swap(__float_as_uint(m), __float_as_uint(m), false, false); return fmaxf(__uint_as_float(rr[0]), __uint_as_float(rr[1])); }
__device__ __forceinline__ float swapadd(float m) { auto rr = __builtin_amdgcn_permlane32_swap(__float_as_uint(m), __float_as_uint(m), false, false); return __uint_as_float(rr[0]) + __uint_as_float(rr[1]); }
__device__ __forceinline__ int rel_bucket(int n) { if (n < 16) return n; const int l = 16 + (int)(logf((float)n / 16.f) / 2.0794415416798357f * 16.f); return l < 31 ? l : 31; }

template <bool SAMPLE>
__device__ __forceinline__ void attn_unit(const Frame& F, int a0, int a1, LAS unsigned char* vst, const LAS float* tab) {
    const int lane = F.lane, q = lane & 31, hi = lane >> 5;
    const bf16* PROJ = F.PROJ;
    int h, hk, qrow, dmax, ts;
    if (!SAMPLE) { h = a1; hk = h >> 2; qrow = a0 * 32 + q; const int tq = qrow % LSEQ; dmax = tq < 127 ? tq : 127; ts = q; }
    else { hk = a1; const int qq = q & 15; h = hk * 4 + (qq >> 2); ts = qq & 3; qrow = NPR + a0 * 4 + ts; dmax = 127; }
    const bf16* qp = PROJ + (size_t)qrow * DIN + QOFF + h * 64 + hi * 8;
    bf16x8 qr[4];
#pragma unroll
    for (int d0 = 0; d0 < 4; ++d0) qr[d0] = *(const GAS bf16x8*)(qp + d0 * 16);
    f32x16 S[5];
#pragma unroll
    for (int i = 0; i < 5; ++i) {
        bf16x8 kf[4];
        if (!SAMPLE) { int kr = a0 * 32 - 128 + 32 * i + q; kr = kr < 0 ? 0 : kr; const bf16* kp = PROJ + (size_t)kr * DIN + KOFF + hk * 64 + hi * 8;
#pragma unroll
            for (int d0 = 0; d0 < 4; ++d0) kf[d0] = *(const GAS bf16x8*)(kp + d0 * 16); }
        else if (i < 4) { const float* kp = F.ck + (((size_t)a0 * 128 + 32 * i + q) * 2 + hk) * 64 + hi * 8;
#pragma unroll
            for (int d0 = 0; d0 < 4; ++d0) kf[d0] = ldcvt8(kp + d0 * 16); }
        else { const bf16* kp = PROJ + (size_t)(NPR + a0 * 4 + (q & 3)) * DIN + KOFF + hk * 64 + hi * 8;
#pragma unroll
            for (int d0 = 0; d0 < 4; ++d0) kf[d0] = *(const GAS bf16x8*)(kp + d0 * 16); }
        f32x16 acc = {0.f, 0.f, 0.f, 0.f, 0.f, 0.f, 0.f, 0.f, 0.f, 0.f, 0.f, 0.f, 0.f, 0.f, 0.f, 0.f};
#pragma unroll
        for (int d0 = 0; d0 < 4; ++d0) acc = __builtin_amdgcn_mfma_f32_32x32x16_bf16(kf[d0], qr[d0], acc, 0, 0, 0);
        S[i] = acc;
    }
    const float SC = 0.125f * LOG2E;
    const int dl = ts + 128 - 4 * hi;
    const LAS float* tp = tab + h * 192 + (31 - ts + 4 * hi);
    float mx = -INFINITY;
#pragma unroll
    for (int i = 0; i < 5; ++i)
#pragma unroll
        for (int r = 0; r < 16; ++r) { const int c = 32 * i + (r & 3) + 8 * (r >> 2); const int dist = dl - c; const bool ok = (unsigned)dist <= (unsigned)dmax;
            const float s = ok ? fmaf(S[i][r], SC, tp[c]) : -INFINITY; S[i][r] = s; mx = fmaxf(mx, s); }
    mx = swapmax(mx);
    const float sk = F.sinks[h] * LOG2E; mx = fmaxf(mx, sk);
    float sum = 0.f;
#pragma unroll
    for (int i = 0; i < 5; ++i)
#pragma unroll
        for (int r = 0; r < 16; ++r) { const float p = __builtin_amdgcn_exp2f(S[i][r] - mx); S[i][r] = p; sum += p; }
    sum = swapadd(sum);
    const float inv = 1.0f / (sum + __builtin_amdgcn_exp2f(sk - mx));
    f32x16 o[2];
    o[0] = (f32x16){0.f, 0.f, 0.f, 0.f, 0.f, 0.f, 0.f, 0.f, 0.f, 0.f, 0.f, 0.f, 0.f, 0.f, 0.f, 0.f}; o[1] = o[0];
    const LAS unsigned char* vrd = vst + ((lane >> 4) & 1) * 32 + (lane & 3) * 8 + (4 * hi + ((lane & 15) >> 2)) * 64;
#pragma unroll
    for (int i = 0; i < 5; ++i) {
        v4u vv[4];
#pragma unroll
        for (int pc = 0; pc < 4; ++pc) { const int dh = pc >> 1, rg = pc & 1, jr = 16 * rg + (lane >> 2), cc = dh * 32 + (lane & 3) * 8;
            if (!SAMPLE) { int vr = a0 * 32 - 128 + 32 * i + jr; vr = vr < 0 ? 0 : vr; vv[pc] = *(const GAS v4u*)(PROJ + (size_t)vr * DIN + VOFF + hk * 64 + cc); }
            else if (i < 4) vv[pc] = __builtin_bit_cast(v4u, ldcvt8(F.cv + (((size_t)a0 * 128 + 32 * i + jr) * 2 + hk) * 64 + cc));
            else vv[pc] = *(const GAS v4u*)(PROJ + (size_t)(NPR + a0 * 4 + (jr & 3)) * DIN + VOFF + hk * 64 + cc); }
#pragma unroll
        for (int pc = 0; pc < 4; ++pc) *(LAS v4u*)(vst + pc * 1024 + lane * 16) = vv[pc];
#pragma unroll
        for (int s2 = 0; s2 < 2; ++s2) {
            v4u pw; pw.x = cvtpk(S[i][8 * s2 + 0], S[i][8 * s2 + 1]); pw.y = cvtpk(S[i][8 * s2 + 2], S[i][8 * s2 + 3]); pw.z = cvtpk(S[i][8 * s2 + 4], S[i][8 * s2 + 5]); pw.w = cvtpk(S[i][8 * s2 + 6], S[i][8 * s2 + 7]);
            const bf16x8 pf = __builtin_bit_cast(bf16x8, pw);
#pragma unroll
            for (int d0 = 0; d0 < 2; ++d0) { const s16x4 lo = vtr(vrd + d0 * 2048 + s2 * 1024), hh = vtr(vrd + d0 * 2048 + s2 * 1024 + 512);
                const bf16x8 vf = (bf16x8){lo[0], lo[1], lo[2], lo[3], hh[0], hh[1], hh[2], hh[3]};
                o[d0] = __builtin_amdgcn_mfma_f32_32x32x16_bf16(vf, pf, o[d0], 0, 0, 0); }
        }
    }
    if (!SAMPLE || q < 16) { bf16* op = F.MIX + (size_t)qrow * D + DPOOL + h * 64 + 4 * hi;
#pragma unroll
        for (int d0 = 0; d0 < 2; ++d0)
#pragma unroll
            for (int g4 = 0; g4 < 4; ++g4) { u32x2 w; w.x = cvtpk(o[d0][4 * g4] * inv, o[d0][4 * g4 + 1] * inv); w.y = cvtpk(o[d0][4 * g4 + 2] * inv, o[d0][4 * g4 + 3] * inv);
                *(GAS u32x2*)(op + d0 * 32 + 8 * g4) = w; } }
}

template <bool SAMPLE>
__device__ __forceinline__ void pool_unit(const Frame& F, int blk, int g) {
    const int lane = F.lane, q = lane & 31, hi = lane >> 5, w = 2 << g;
    const bf16* PROJ = F.PROJ;
    int qrow, n, db = 0, sx = 0;
    if (!SAMPLE) { qrow = blk * 32 + q; const int tq = qrow % LSEQ; n = (tq + 1) < w ? (tq + 1) : w; }
    else { const int r = blk * 32 + q; db = r >> 2; sx = r & 3; qrow = NPR + r; n = w; }
    const float rc = 1.0f / (float)n;
    f32x16 acc[4];
#pragma unroll
    for (int nb = 0; nb < 4; ++nb) acc[nb] = (f32x16){0.f, 0.f, 0.f, 0.f, 0.f, 0.f, 0.f, 0.f, 0.f, 0.f, 0.f, 0.f, 0.f, 0.f, 0.f, 0.f};
#pragma unroll 2
    for (int s = 0; s < 8; ++s) {
        const int c0 = g * 128 + 16 * s + 8 * hi;
        const v4u cu = *(const GAS v4u*)(PROJ + (size_t)qrow * DIN + c0);
        float cur[8] = {bflo(cu.x), bfhi(cu.x), bflo(cu.y), bfhi(cu.y), bflo(cu.z), bfhi(cu.z), bflo(cu.w), bfhi(cu.w)};
        float sum[8];
#pragma unroll
        for (int e = 0; e < 8; ++e) sum[e] = cur[e];
#pragma unroll 4
        for (int i = 1; i < w; ++i) {
            if (!SAMPLE) { const float okf = i < n ? 1.f : 0.f; const int rr = i < n ? qrow - i : qrow; const v4u x = *(const GAS v4u*)(PROJ + (size_t)rr * DIN + c0);
                sum[0] += okf * bflo(x.x); sum[1] += okf * bfhi(x.x); sum[2] += okf * bflo(x.y); sum[3] += okf * bfhi(x.y); sum[4] += okf * bflo(x.z); sum[5] += okf * bfhi(x.z); sum[6] += okf * bflo(x.w); sum[7] += okf * bfhi(x.w); }
            else { const int idx = 15 + sx - i;
                if (idx >= 15) { const v4u x = *(const GAS v4u*)(PROJ + (size_t)(NPR + db * 4 + idx - 15) * DIN + c0);
                    sum[0] += bflo(x.x); sum[1] += bfhi(x.x); sum[2] += bflo(x.y); sum[3] += bfhi(x.y); sum[4] += bflo(x.z); sum[5] += bfhi(x.z); sum[6] += bflo(x.w); sum[7] += bfhi(x.w); }
                else { const float* sp = F.spool + ((size_t)db * 15 + idx) * 512 + c0; const f32x4 a = *(const GAS f32x4*)sp, b = *(const GAS f32x4*)(sp + 4);
                    sum[0] += a.x; sum[1] += a.y; sum[2] += a.z; sum[3] += a.w; sum[4] += b.x; sum[5] += b.y; sum[6] += b.z; sum[7] += b.w; } }
        }
        v4u pw; pw.x = cvtpk(sum[0] * rc - cur[0], sum[1] * rc - cur[1]); pw.y = cvtpk(sum[2] * rc - cur[2], sum[3] * rc - cur[3]); pw.z = cvtpk(sum[4] * rc - cur[4], sum[5] * rc - cur[5]); pw.w = cvtpk(sum[6] * rc - cur[6], sum[7] * rc - cur[7]);
        const bf16x8 pf = __builtin_bit_cast(bf16x8, pw);
#pragma unroll
        for (int nb = 0; nb < 4; ++nb) { const bf16x8 wf = *(const GAS bf16x8*)(F.WPOOL_T + (size_t)(g * 128 + nb * 32 + q) * 128 + 16 * s + 8 * hi);
            acc[nb] = __builtin_amdgcn_mfma_f32_32x32x16_bf16(wf, pf, acc[nb], 0, 0, 0); }
    }
    bf16* op = F.MIX + (size_t)qrow * D + g * 128 + 4 * hi; const float* sc = F.pscale + g * 128 + 4 * hi;
#pragma unroll
    for (int nb = 0; nb < 4; ++nb)
#pragma unroll
        for (int g4 = 0; g4 < 4; ++g4) { const f32x4 s4 = *(const GAS f32x4*)(sc + nb * 32 + 8 * g4);
            u32x2 wv; wv.x = cvtpk(acc[nb][4 * g4] * s4.x, acc[nb][4 * g4 + 1] * s4.y); wv.y = cvtpk(acc[nb][4 * g4 + 2] * s4.z, acc[nb][4 * g4 + 3] * s4.w);
            *(GAS u32x2*)(op + nb * 32 + 8 * g4) = wv; }
}
}

__device__ __forceinline__ void p2_mixers(Frame& F) {
    LAS float* tab = (LAS float*)(F.lds + TAB_OFF);
    for (int e = F.tid; e < 8 * 192; e += NWAVES * 64) { const int h = e / 192, x = e - h * 192, dist = 159 - x; float v = 0.f;
        if (dist >= 0 && dist < 128) v = F.rel[mixer::rel_bucket(dist) * 8 + h] * LOG2E; tab[e] = v; }
    __syncthreads();
    LAS unsigned char* vst = F.lds + F.wave * 4096;
    const int gw = F.vcu * NWAVES + F.wave, NGW = F.G * NWAVES;
    constexpr int NA = (NPR / 32) * 8, NB = 128 * 2, NC = (NPR / 32) * 4, ND = (NSR / 32) * 4, NU = NA + NB + NC + ND;
#define FIRST_U(lo) ((lo) <= gw ? gw : gw + (((lo) - gw + NGW - 1) / NGW) * NGW)
    for (int u = gw; u < NA; u += NGW) mixer::attn_unit<false>(F, u >> 3, u & 7, vst, tab);
    for (int u = FIRST_U(NA); u < NA + NB; u += NGW) { const int v = u - NA; mixer::attn_unit<true>(F, v >> 1, v & 1, vst, tab); }
    for (int u = FIRST_U(NA + NB); u < NA + NB + NC; u += NGW) { const int v = u - NA - NB; mixer::pool_unit<false>(F, v >> 2, v & 3); }
    for (int u = FIRST_U(NA + NB + NC); u < NU; u += NGW) { const int v = u - NA - NB - NC; mixer::pool_unit<true>(F, v >> 2, v & 3); }
#undef FIRST_U
    const int gt = gw * 64 + F.lane, NGT = NGW * 64;
    constexpr int N1 = 8 * 128 * 128 / 8, N2 = 8 * 15 * 512 / 8, N3 = 128 * 4 * 128 / 8, N4 = 128 * 4 * 512 / 8, NT = 2 * N1 + N2 + 2 * N3 + N4;
    for (int i = gt; i < NT; i += NGT) {
        const bf16* src; float* dst; int j = i;
        if (j < 2 * N1) { const int which = j >= N1; j -= which * N1; const int b = j / (128 * 16), rem = j - b * (128 * 16), r = rem >> 4, c8 = rem & 15;
            src = F.PROJ + (size_t)(b * LSEQ + (LSEQ - 128) + r) * DIN + (which ? VOFF : KOFF) + c8 * 8; dst = F.out + (which ? O_VP : O_KP) + (size_t)j * 8; }
        else if ((j -= 2 * N1) < N2) { const int b = j / (15 * 64), rem = j - b * (15 * 64), r = rem >> 6, c8 = rem & 63;
            src = F.PROJ + (size_t)(b * LSEQ + (LSEQ - 15) + r) * DIN + c8 * 8; dst = F.out + O_PP + (size_t)j * 8; }
        else if ((j -= N2) < 2 * N3) { const int which = j >= N3; j -= which * N3; const int db = j / (4 * 16), rem = j - db * (4 * 16), s = rem >> 4, c8 = rem & 15;
            src = F.PROJ + (size_t)(NPR + db * 4 + s) * DIN + (which ? VOFF : KOFF) + c8 * 8; dst = F.out + (which ? O_VS : O_KS) + ((size_t)db * 128 + 124 + s) * 128 + c8 * 8; }
        else { j -= 2 * N3; const int db = j / (4 * 64), rem = j - db * (4 * 64), s = rem >> 6, c8 = rem & 63;
            src = F.PROJ + (size_t)(NPR + db * 4 + s) * DIN + c8 * 8; dst = F.out + O_PS + ((size_t)db * 15 + 11 + s) * 512 + c8 * 8; }
        const v4u x = *(const GAS v4u*)src;
        f32x4 a = {mixer::bflo(x.x), mixer::bfhi(x.x), mixer::bflo(x.y), mixer::bfhi(x.y)}, b = {mixer::bflo(x.z), mixer::bfhi(x.z), mixer::bflo(x.w), mixer::bfhi(x.w)};
        *(GAS f32x4*)dst = a; *(GAS f32x4*)(dst + 4) = b;
    }
}

struct Args { const float* in[20]; float* out; unsigned char* ws; int ph_lo, ph_hi; };
__global__ void __launch_bounds__(NWAVES * 64, 2) hymba_fwd(Args args) {
    extern __shared__ __attribute__((aligned(16))) unsigned char lds[];
    Frame F;
    F.lds = (LAS unsigned char*)lds;
    F.MISC = (volatile LAS unsigned*)(F.lds + MISC_OFF);
    F.tid = threadIdx.x; F.lane = F.tid & 63; F.wave = __builtin_amdgcn_readfirstlane(F.tid >> 6);
    F.G = gridDim.x; { const int bx = blockIdx.x; F.vcu = (F.G % 8 == 0) ? (bx % 8) * (F.G / 8) + bx / 8 : bx; }
    unsigned char* ws = args.ws;
    F.ctl = (gu32*)(ws + WS_CTL);
    F.xp = args.in[0]; F.xs = args.in[1]; F.ck = args.in[2]; F.cv = args.in[3]; F.spool = args.in[4]; F.meta = args.in[5]; F.eg = args.in[6]; F.eb = args.in[7]; F.rel = args.in[8]; F.w_in = args.in[9];
    F.w_pool = args.in[10]; F.pscale = args.in[11]; F.sinks = args.in[12]; F.w_out = args.in[13]; F.g1 = args.in[14]; F.b1 = args.in[15]; F.w1 = args.in[16]; F.w2 = args.in[17]; F.g2 = args.in[18]; F.b2 = args.in[19];
    F.out = args.out;
    F.WIN_T = (bf16*)(ws + WS_WIN); F.WOUT_T = (bf16*)(ws + WS_WOUT); F.W1_T = (bf16*)(ws + WS_W1); F.W2_T = (bf16*)(ws + WS_W2); F.WPOOL_T = (bf16*)(ws + WS_WPOOL);
    F.R1 = (bf16*)(ws + WS_R1); F.H1 = (bf16*)(ws + WS_H1); F.H0 = (bf16*)(ws + WS_H0); F.PROJ = (bf16*)(ws + WS_PROJ); F.MIX = (bf16*)(ws + WS_MIX); F.ACT = (bf16*)(ws + WS_ACT);
    for (int u = F.tid; u < (LDS_BYTES - LDSCTL_OFF) / 4; u += NWAVES * 64) ((LAS unsigned*)(F.lds + LDSCTL_OFF))[u] = 0u;
    __syncthreads();
    XcdBarrier bar; bar.bar = (unsigned*)(F.ctl + CW_BAR); bar.x = 0; bar.st = nullptr;
    if (N_LAUNCHES == 1) bar = xcd_barrier_post((unsigned*)(F.ctl + CW_BAR), F.MISC + 8);
    const int lo = args.ph_lo, hi = args.ph_hi;
#define IN(k) (lo <= (k) && (k) < hi)
#define SEAM(k) do { if (IN(k) && IN((k) + 1)) xcd_barrier(bar); } while (0)
    const int gw = F.vcu * NWAVES + F.wave, NGW = F.G * NWAVES;

    if (IN(0)) { p0_prologue(F); } SEAM(0);
    if (IN(1)) { pg8::Gemm g{F.H0, F.WIN_T, MP, DIN, D}; pg8::StaticOrder S; S.init(MP, DIN, F.G, (int)blockIdx.x);
        pg8::EpiB<0> E{F.PROJ, DIN, nullptr, 0};
        pg8::gemm_phase<pg8::EpiB<0>, pg8::StaticOrder, true, true>(F.lds, g, S, E); } SEAM(1);
    if (IN(2)) { p2_mixers(F); } SEAM(2);
    if (IN(3)) { pg8::Gemm g{F.MIX, F.WOUT_T, MP, D, D}; pg8::StaticOrder S; S.init(MP, D, F.G, (int)blockIdx.x);
        pg8::EpiB<2> E{F.R1, D, F.H0, D};
        pg8::gemm_phase<pg8::EpiB<2>, pg8::StaticOrder, true, true>(F.lds, g, S, E); } SEAM(3);
    if (IN(4)) { for (int m = gw; m < MP; m += NGW) ln_bf16row_to_bf16(F.R1 + (size_t)m * D, F.H1 + (size_t)m * D, F.g1, F.b1, F.lane); } SEAM(4);
    if (IN(5)) { pg8::Gemm g{F.H1, F.W1_T, MP, DFF, D}; pg8::StaticOrder S; S.init(MP, DFF, F.G, (int)blockIdx.x);
        pg8::EpiB<1> E{F.ACT, DFF, nullptr, 0};
        pg8::gemm_phase<pg8::EpiB<1>, pg8::StaticOrder, true, true>(F.lds, g, S, E); } SEAM(5);
    if (IN(6)) { pg8::Gemm g{F.ACT, F.W2_T, MP, D, DFF}; pg8::StaticOrder S; S.init(MP, D, F.G, (int)blockIdx.x);
        pg8::EpiOut E{F.out, F.H1};
        pg8::gemm_phase<pg8::EpiOut, pg8::StaticOrder, true, true>(F.lds, g, S, E); } SEAM(6);
    if (IN(7)) { for (int r = gw; r < 16384 + 512; r += NGW) ln_f32row_inplace(F.out + (size_t)r * D, F.g2, F.b2, F.lane); }
#undef IN
#undef SEAM
}

extern "C" void kernel_launch(void* const* d_in, const int* in_sizes, int n_in, void* d_out, int out_size, void* d_ws, size_t ws_size, hipStream_t stream) {
    static int grid = 0;
    if (grid == 0) {
        if (n_in != 20 || ws_size < WS_END) { fprintf(stderr, "kernel_launch: unexpected problem (n_in %d, ws %zu)\n", n_in, ws_size); grid = -1; return; }
        int dev = 0, cus = 0, per_cu = 0;
        if (hipGetDevice(&dev) != hipSuccess || hipDeviceGetAttribute(&cus, hipDeviceAttributeMultiprocessorCount, dev) != hipSuccess) { grid = -1; return; }
        if (hipFuncSetAttribute((const void*)hymba_fwd, hipFuncAttributeMaxDynamicSharedMemorySize, LDS_BYTES) != hipSuccess) { fprintf(stderr, "kernel_launch: hipFuncSetAttribute failed\n"); grid = -1; return; }
        if (hipOccupancyMaxActiveBlocksPerMultiprocessor(&per_cu, (const void*)hymba_fwd, NWAVES * 64, LDS_BYTES) != hipSuccess || per_cu < 1) { fprintf(stderr, "kernel_launch: occupancy query says %d workgroups per CU\n", per_cu); per_cu = 1; }
        (void)hipGetLastError();
        grid = cus;
    }
    if (grid < 0) return;
    if (hipMemsetAsync((char*)d_ws + WS_CTL, 0, CTL_ZERO_BYTES, stream) != hipSuccess) { fprintf(stderr, "kernel_launch: memset failed\n"); return; }
    Args a{};
    for (int i = 0; i < 20; ++i) a.in[i] = (const float*)d_in[i];
    a.out = (float*)d_out; a.ws = (unsigned char*)d_ws;
    for (int li = 0; li < N_LAUNCHES; ++li) {
        a.ph_lo = (N_LAUNCHES == 1) ? 0 : li; a.ph_hi = (N_LAUNCHES == 1) ? N_PHASES : li + 1;
        hipLaunchKernelGGL(hymba_fwd, dim3(grid), dim3(NWAVES * 64), LDS_BYTES, stream, a);
        const hipError_t le = hipPeekAtLastError();
        if (le != hipSuccess) { fprintf(stderr, "kernel_launch: launch %d failed: %s\n", li, hipGetErrorName(le)); break; }
    }
}
```

```cpp
#include <hip/hip_runtime.h>
#include <cstdio>
#include <cstdint>
namespace pg8 {
#define PG8_LAS __attribute__((address_space(3)))
typedef unsigned short bf16_t;
typedef short bf16x8 __attribute__((ext_vector_type(8)));
typedef float f32x4 __attribute__((ext_vector_type(4)));
typedef unsigned u32x4 __attribute__((ext_vector_type(4)));
constexpr int BM = 256, BK = 64, HALF = 128, HTB = HALF * BK * 2  , STAGE_BYTES = 8 * HTB, NXCD = 8, WGM = 8;

__host__ __device__ __forceinline__ int lds_byte(int r, int c) { const int st = (r >> 4) * 2 + (c >> 5), rr = r & 15, cc = c & 31, ob = rr * 64 + cc * 2; return st * 1024 + (ob ^ (((ob >> 9) & 1) << 5)); }
__host__ __device__ __forceinline__ void stage_rc(int b, int& R, int& C) { const int st = b / 1024, sb = b % 1024, swz = sb ^ (((sb >> 9) & 1) << 5); R = (st >> 1) * 16 + swz / 64; C = (st & 1) * 32 + (swz % 64) / 2; }
__host__ __device__ __forceinline__ int perm32(int rho) { const int n = rho >> 4, i = rho & 15; return 8 * (i >> 2) + 4 * n + (i & 3); }

struct Unit { int pm, pn; };
struct Gemm { const bf16_t* A; const bf16_t* Bt; int M, N, K; };

struct StaticOrder {
    int nM, nN, nwg, G, c;
    __host__ __device__ void init(int M, int N, int G_, int c_) { nM = M / BM; nN = N / BM; nwg = nM * nN; G = G_; c = c_; }
    __host__ __device__ bool next(int i, Unit& u) const {
        const long L = (long)i * G + c; if (L >= nwg) return false;
        int wgid = (int)L; { const int q = nwg / NXCD, r = nwg % NXCD, xcd = wgid % NXCD, off = wgid / NXCD; wgid = (xcd < r ? xcd * (q + 1) : r * (q + 1) + (xcd - r) * q) + off; }
        const int nig = WGM * nN, gid = wgid / nig, fm = gid * WGM, gsz = (nM - fm) < WGM ? (nM - fm) : WGM;
        u.pm = fm + ((wgid % nig) % gsz); u.pn = (wgid % nig) / gsz; return true;
    }
    __device__ __forceinline__ void a_ready(const Unit&) const {}
    __device__ __forceinline__ void done(const Unit&) const {}
};

__device__ __forceinline__ unsigned cvt_pk_bf16(float lo, float hi) { unsigned r; asm volatile("v_cvt_pk_bf16_f32 %0, %1, %2" : "=v"(r) : "v"(lo), "v"(hi)); return r; }
typedef float f32x2 __attribute__((ext_vector_type(2)));
typedef unsigned u32x2 __attribute__((ext_vector_type(2)));
constexpr float kAlpha = 1.189207115002721f;
__device__ __forceinline__ float bf_lo(unsigned x) { return __uint_as_float(x << 16); }
__device__ __forceinline__ float bf_hi(unsigned x) { return __uint_as_float(x & 0xffff0000u); }
template <int MODE> struct EpiB {
    static constexpr bool PERM = true, AFTER_DRAIN = false;
    bf16_t* O; int ldc; const bf16_t* res; int ldr;
    __device__ __forceinline__ void operator()(const f32x4 (&acc)[2][2][4][2], const Unit& u, int wr, int wc, int fr, int fq) const {
        const int row0 = u.pm * BM + wr * 64 + fr, col0 = u.pn * BM + wc * 32 + 8 * fq;
#pragma unroll
        for (int ai = 0; ai < 2; ++ai)
#pragma unroll
            for (int m = 0; m < 4; ++m) { const size_t row = (size_t)(row0 + ai * HALF + m * 16); bf16_t* rowp = O + row * ldc + col0;
#pragma unroll
                for (int bj = 0; bj < 2; ++bj) { f32x4 v0 = acc[ai][bj][m][0], v1 = acc[ai][bj][m][1];
                    if (MODE == 1) {
#pragma unroll
                        for (int e = 0; e < 4; ++e) { const float a = v0[e] > 0.f ? v0[e] : 0.f, b = v1[e] > 0.f ? v1[e] : 0.f; v0[e] = a * a; v1[e] = b * b; } }
                    if (MODE == 2) { const u32x4 rv = *(const u32x4*)(res + row * ldr + col0 + bj * HALF);
                        v0[0] += kAlpha * bf_lo(rv.x); v0[1] += kAlpha * bf_hi(rv.x); v0[2] += kAlpha * bf_lo(rv.y); v0[3] += kAlpha * bf_hi(rv.y);
                        v1[0] += kAlpha * bf_lo(rv.z); v1[1] += kAlpha * bf_hi(rv.z); v1[2] += kAlpha * bf_lo(rv.w); v1[3] += kAlpha * bf_hi(rv.w); }
                    u32x4 w; w.x = cvt_pk_bf16(v0[0], v0[1]); w.y = cvt_pk_bf16(v0[2], v0[3]); w.z = cvt_pk_bf16(v1[0], v1[1]); w.w = cvt_pk_bf16(v1[2], v1[3]);
                    *(u32x4*)(rowp + bj * HALF) = w; } }
    }
};
struct EpiOut {
    static constexpr bool PERM = false, AFTER_DRAIN = false;
    float* out; const bf16_t* res;
    static __device__ __forceinline__ float* out_row(float* out, int row) {
        if (row < 16512) { const int b = row / 2064, t = row - b * 2064; return t < 16 ? nullptr : out + ((size_t)b * 2048 + (t - 16)) * 1024; }
        if (row < 17024) return out + 16777216 + (size_t)(row - 16512) * 1024;
        return nullptr;
    }
    __device__ __forceinline__ void operator()(const f32x4 (&acc)[2][2][4][2], const Unit& u, int wr, int wc, int fr, int fq) const {
        const int row0 = u.pm * BM + wr * 64 + fr, col0 = u.pn * BM + wc * 32 + 4 * fq;
#pragma unroll
        for (int ai = 0; ai < 2; ++ai)
#pragma unroll
            for (int m = 0; m < 4; ++m) { const int row = row0 + ai * HALF + m * 16; float* op = out_row(out, row);
                if (op) {
#pragma unroll
                    for (int bj = 0; bj < 2; ++bj)
#pragma unroll
                        for (int n = 0; n < 2; ++n) { const int col = col0 + bj * HALF + n * 16; const u32x2 rv = *(const u32x2*)(res + (size_t)row * 1024 + col); f32x4 v = acc[ai][bj][m][n];
                            v[0] += kAlpha * bf_lo(rv.x); v[1] += kAlpha * bf_hi(rv.x); v[2] += kAlpha * bf_lo(rv.y); v[3] += kAlpha * bf_hi(rv.y);
                            *(f32x4*)(op + col) = v; } } }
    }
};

template <class Epi, class Sched, bool ALIGN_EPI = false, bool SP2 = false>
__device__ __forceinline__ void gemm_phase(PG8_LAS unsigned char* lds, const Gemm g, const Sched& S, const Epi& E) {
    const int tid = threadIdx.x, wid = __builtin_amdgcn_readfirstlane(tid >> 6), lane = tid & 63, wr = wid >> 2, wc = wid & 3, fr = lane & 15, fq = lane >> 4;
    const int K = g.K, nt = K / BK;
    unsigned voffA[2], voffB[2];
#pragma unroll
    for (int i = 0; i < 2; ++i) { int R, C; stage_rc(tid * 16 + i * 8192, R, C); const int Rb = Epi::PERM ? ((R & ~31) + perm32(R & 31)) : R;
        voffA[i] = (unsigned)(R * K + C) * 2u; voffB[i] = (unsigned)(Rb * K + C) * 2u; }
    const size_t kstep = (size_t)(BK * 2);
    const size_t hstep = (size_t)HALF * K * 2;
    const size_t tstep = 2 * hstep;
    const unsigned ldsw = (unsigned)wid * 1024u;
    const int aoff = lds_byte(wr * 64 + fr, fq * 8), boff = lds_byte(wc * 32 + fr, fq * 8);
#define PG8_SA(b, h) (((b) * 2 + (h)) * HTB)
#define PG8_SB(b, h) ((4 + (b) * 2 + (h)) * HTB)
#define PG8_STAGE(bufoff, gbase, voff) do { _Pragma("unroll") for (int _i = 0; _i < 2; ++_i) \
        __builtin_amdgcn_global_load_lds((const unsigned*)((const char*)(gbase) + (voff)[_i]), (PG8_LAS unsigned*)(lds + (bufoff) + ldsw + _i * 8192), 16, 0, 0); } while (0)
#define PG8_LDA(dst, b, h) do { _Pragma("unroll") for (int m = 0; m < 4; ++m) _Pragma("unroll") for (int k = 0; k < 2; ++k) dst[m][k] = *(const PG8_LAS bf16x8*)(lds + PG8_SA(b, h) + aoff + m * 2048 + k * 1024); } while (0)
#define PG8_LDB(dst, b, h) do { _Pragma("unroll") for (int n = 0; n < 2; ++n) _Pragma("unroll") for (int k = 0; k < 2; ++k) dst[n][k] = *(const PG8_LAS bf16x8*)(lds + PG8_SB(b, h) + boff + n * 2048 + k * 1024); } while (0)
#define PG8_MMA(ai, bj, At, Bt) do { __builtin_amdgcn_s_setprio(1); _Pragma("unroll") for (int m = 0; m < 4; ++m) _Pragma("unroll") for (int n = 0; n < 2; ++n) _Pragma("unroll") for (int k = 0; k < 2; ++k) \
        acc[ai][bj][m][n] = __builtin_amdgcn_mfma_f32_16x16x32_bf16(Bt[n][k], At[m][k], acc[ai][bj][m][n], 0, 0, 0); __builtin_amdgcn_s_setprio(0); } while (0)
#define PG8_WAIT_V(n) asm volatile("s_waitcnt vmcnt(" #n ")" ::: "memory")
#define PG8_WAIT_L(n) asm volatile("s_waitcnt lgkmcnt(" #n ")" ::: "memory")
#define PG8_BAR __builtin_amdgcn_s_barrier()
#define PG8_SCHED __builtin_amdgcn_sched_barrier(0)
    Unit cur, nxt; int ui = 0;
    if (!S.next(0, cur)) return;
    f32x4 acc[2][2][4][2];
#pragma unroll
    for (int a = 0; a < 2; ++a)
#pragma unroll
        for (int b = 0; b < 2; ++b)
#pragma unroll
            for (int m = 0; m < 4; ++m)
#pragma unroll
                for (int n = 0; n < 2; ++n) acc[a][b][m][n] = (f32x4){0.f, 0.f, 0.f, 0.f};
    bf16x8 At[4][2], B0[2][2], B1[2][2];
    const char* cA = (const char*)g.A + (size_t)cur.pm * tstep; const char* cB = (const char*)g.Bt + (size_t)cur.pn * tstep;
    S.a_ready(cur);
    if constexpr (SP2) {
        PG8_STAGE(PG8_SB(0, 0), cB, voffB); PG8_STAGE(PG8_SB(0, 1), cB + hstep, voffB); PG8_STAGE(PG8_SA(0, 0), cA, voffA); PG8_STAGE(PG8_SA(0, 1), cA + hstep, voffA);
        if (wr == 1) PG8_BAR;
        PG8_WAIT_V(2); PG8_BAR;
        PG8_STAGE(PG8_SB(1, 0), cB + kstep, voffB); PG8_STAGE(PG8_SA(1, 0), cA + kstep, voffA); PG8_STAGE(PG8_SB(1, 1), cB + hstep + kstep, voffB);
        PG8_WAIT_V(6); PG8_BAR;
    } else {
        PG8_STAGE(PG8_SB(0, 0), cB, voffB); PG8_STAGE(PG8_SA(0, 0), cA, voffA); PG8_STAGE(PG8_SB(0, 1), cB + hstep, voffB); PG8_STAGE(PG8_SA(0, 1), cA + hstep, voffA);
        if (wr == 1) PG8_BAR;
        PG8_WAIT_V(4); PG8_BAR;
        PG8_STAGE(PG8_SB(1, 0), cB + kstep, voffB); PG8_STAGE(PG8_SA(1, 0), cA + kstep, voffA); PG8_STAGE(PG8_SB(1, 1), cB + hstep + kstep, voffB);
        PG8_WAIT_V(6); PG8_BAR;
    }
    for (;;) {
        const bool has_next = S.next(ui + 1, nxt);
        const char* nA = has_next ? (const char*)g.A + (size_t)nxt.pm * tstep : cA; const char* nB = has_next ? (const char*)g.Bt + (size_t)nxt.pn * tstep : cB;
        for (int t = 0; t < nt; t += 2) {
            const bool last = (t == nt - 2);
            const char* a1 = cA + (size_t)(t + 1) * kstep;
            const char* a2 = last ? nA : cA + (size_t)(t + 2) * kstep; const char* b2 = last ? nB : cB + (size_t)(t + 2) * kstep;
            const char* a3 = a2 + kstep; const char* b3 = b2 + kstep;
            if (last && has_next) S.a_ready(nxt);
            if constexpr (SP2) {
            PG8_LDB(B0, 0, 0); PG8_LDB(B1, 0, 1); PG8_SCHED; PG8_LDA(At, 0, 0); PG8_STAGE(PG8_SA(1, 1), a1 + hstep, voffA);
            PG8_WAIT_V(8); PG8_WAIT_L(0); PG8_BAR; PG8_MMA(0, 0, At, B0); PG8_MMA(0, 1, At, B1); PG8_BAR; PG8_SCHED;
            PG8_LDA(At, 0, 1); PG8_STAGE(PG8_SB(0, 0), b2, voffB); PG8_STAGE(PG8_SB(0, 1), b2 + hstep, voffB); PG8_STAGE(PG8_SA(0, 0), a2, voffA);
            PG8_WAIT_V(8); PG8_WAIT_L(0); PG8_BAR; PG8_MMA(1, 0, At, B0); PG8_MMA(1, 1, At, B1); PG8_BAR; PG8_SCHED;
            PG8_LDB(B0, 1, 0); PG8_LDB(B1, 1, 1); PG8_SCHED; PG8_LDA(At, 1, 0); PG8_STAGE(PG8_SA(0, 1), a2 + hstep, voffA);
            PG8_WAIT_V(8); PG8_WAIT_L(0); PG8_BAR; PG8_MMA(0, 0, At, B0); PG8_MMA(0, 1, At, B1); PG8_BAR; PG8_SCHED;
            PG8_LDA(At, 1, 1); PG8_STAGE(PG8_SB(1, 0), b3, voffB); PG8_STAGE(PG8_SB(1, 1), b3 + hstep, voffB); PG8_STAGE(PG8_SA(1, 0), a3, voffA);
            PG8_WAIT_V(8); PG8_WAIT_L(0); PG8_BAR; PG8_MMA(1, 0, At, B0); PG8_MMA(1, 1, At, B1); PG8_BAR; PG8_SCHED;
            } else {
            PG8_LDB(B0, 0, 0); PG8_SCHED; PG8_LDA(At, 0, 0); PG8_STAGE(PG8_SA(1, 1), a1 + hstep, voffA);
            PG8_WAIT_L(8); PG8_BAR; PG8_WAIT_L(0); PG8_MMA(0, 0, At, B0); PG8_BAR; PG8_SCHED;
            PG8_LDB(B1, 0, 1); PG8_STAGE(PG8_SB(0, 0), b2, voffB);
            PG8_BAR; PG8_WAIT_L(0); PG8_MMA(0, 1, At, B1); PG8_BAR;
            PG8_LDA(At, 0, 1); PG8_STAGE(PG8_SA(0, 0), a2, voffA);
            PG8_BAR; PG8_WAIT_L(0); PG8_MMA(1, 0, At, B0); PG8_BAR; PG8_SCHED;
            PG8_STAGE(PG8_SB(0, 1), b2 + hstep, voffB);
            PG8_WAIT_V(6); PG8_BAR; PG8_MMA(1, 1, At, B1); PG8_BAR;
            PG8_LDB(B0, 1, 0); PG8_SCHED; PG8_LDA(At, 1, 0); PG8_STAGE(PG8_SA(0, 1), a2 + hstep, voffA);
            PG8_WAIT_L(8); PG8_BAR; PG8_WAIT_L(0); PG8_MMA(0, 0, At, B0); PG8_BAR; PG8_SCHED;
            PG8_LDB(B1, 1, 1); PG8_STAGE(PG8_SB(1, 0), b3, voffB);
            PG8_BAR; PG8_WAIT_L(0); PG8_MMA(0, 1, At, B1); PG8_BAR;
            PG8_LDA(At, 1, 1); PG8_STAGE(PG8_SA(1, 0), a3, voffA);
            PG8_BAR; PG8_WAIT_L(0); PG8_MMA(1, 0, At, B0); PG8_BAR; PG8_SCHED;
            PG8_STAGE(PG8_SB(1, 1), b3 + hstep, voffB);
            PG8_WAIT_V(6); PG8_BAR; PG8_MMA(1, 1, At, B1); PG8_BAR;
            }
        }
        if constexpr (ALIGN_EPI) { if (wr == 0) PG8_BAR; }
        if constexpr (!Epi::AFTER_DRAIN) { E(acc, cur, wr, wc, fr, fq); S.done(cur); }
        if (!has_next) break;
#pragma unroll
        for (int a = 0; a < 2; ++a)
#pragma unroll
            for (int b = 0; b < 2; ++b)
#pragma unroll
                for (int m = 0; m < 4; ++m)
#pragma unroll
                    for (int n = 0; n < 2; ++n) acc[a][b][m][n] = (f32x4){0.f, 0.f, 0.f, 0.f};
        cur = nxt; cA = nA; cB = nB; ++ui;
        if constexpr (ALIGN_EPI) { if (wr == 1) PG8_BAR; }
    }
    PG8_WAIT_V(0);
    if constexpr (!ALIGN_EPI) { if (wr == 0) PG8_BAR; }
    PG8_BAR;
    if constexpr (Epi::AFTER_DRAIN) { E.fused(acc, cur, wr, wc, fr, fq, lds, wid, lane); S.done(cur); }
#undef PG8_SA
#undef PG8_SB
#undef PG8_STAGE
#undef PG8_LDA
#undef PG8_LDB
#undef PG8_MMA
#undef PG8_WAIT_V
#undef PG8_WAIT_L
#undef PG8_BAR
#undef PG8_SCHED
}
}
#define GAS __attribute__((address_space(1)))
#define LAS __attribute__((address_space(3)))
typedef unsigned short bf16;
typedef unsigned v4u __attribute__((ext_vector_type(4)));
typedef float f32x4 __attribute__((ext_vector_type(4)));
typedef short bf16x8 __attribute__((ext_vector_type(8)));
typedef GAS unsigned gu32;
typedef GAS unsigned long long gu64;
#define RLX_AGENT __ATOMIC_RELAXED, __HIP_MEMORY_SCOPE_AGENT
#define LDS_WAIT() asm volatile("s_waitcnt lgkmcnt(0)" ::: "memory")
#define VM_WAIT() asm volatile("s_waitcnt vmcnt(0)" ::: "memory")
__device__ __forceinline__ unsigned long long rt() { return __builtin_amdgcn_s_memrealtime(); }
__device__ __forceinline__ unsigned f2bf(float f) { unsigned u = __builtin_bit_cast(unsigned, f); return (u + 0x7fffu + ((u >> 16) & 1u)) >> 16; }
__device__ __forceinline__ unsigned pk2(float lo, float hi) { return f2bf(lo) | (f2bf(hi) << 16); }
#define XB_TMO      128
#define XB_XCNT(j)  (256  + 64 * (j))
#define XB_XSUB(j)  (1280 + 64 * (j))
#define XB_XGEN(j)  (2304 + 64 * (j))
#define XB_TOP      3328
#define XB_TOPGEN   3392
#define XCD_BAR_WORDS 3456
#define XB_SPIN_CAP (1u << 18)

__device__ __forceinline__ unsigned xb_ld(unsigned* p)              { return __hip_atomic_load(p, __ATOMIC_RELAXED, __HIP_MEMORY_SCOPE_AGENT); }
__device__ __forceinline__ unsigned xb_add(unsigned* p, unsigned v) { return __hip_atomic_fetch_add(p, v, __ATOMIC_RELAXED, __HIP_MEMORY_SCOPE_AGENT); }
__device__ __forceinline__ unsigned xb_xcc_id() { return (unsigned)__builtin_amdgcn_s_getreg((3 << 11) | 20) & 0xFu; }
#define XB_SPIN(cond, bar) do { unsigned _sp = 0; while (cond) { __builtin_amdgcn_s_sleep(1); \
    if ((++_sp & 255u) == 0u) { if (xb_ld(&(bar)[XB_TMO])) break; if (_sp > XB_SPIN_CAP) { atomicAdd(&(bar)[XB_TMO], 1u); break; } } } } while (0)

struct XcdBarrier {
    unsigned* bar; unsigned x;
    volatile LAS unsigned* st;
};

__device__ __forceinline__ XcdBarrier xcd_barrier_post(unsigned* bar, volatile LAS unsigned* st) {
    XcdBarrier b; b.bar = bar; b.x = xb_xcc_id(); b.st = st;
    if (threadIdx.x == 0) (void)xb_add(&bar[XB_XCNT(b.x)], 1u);
    return b;
}
__device__ __forceinline__ void xcd_barrier_complete(unsigned* bar, unsigned x, unsigned& nloc, unsigned& nx) {
    const unsigned G = gridDim.x * gridDim.y * gridDim.z;
    unsigned sum, cnt, mine, sp = 0u;
    for (;;) {
        sum = 0u; cnt = 0u; mine = 0u;
#pragma unroll
        for (unsigned j = 0; j < 16; ++j) { const unsigned c = xb_ld(&bar[XB_XCNT(j)]); sum += c; cnt += (c > 0u) ? 1u : 0u; mine = (j == x) ? c : mine; }
        if (sum == G) break;
        __builtin_amdgcn_s_sleep(1);
        if ((++sp & 255u) == 0u) { if (xb_ld(&bar[XB_TMO])) break; if (sp > XB_SPIN_CAP) { atomicAdd(&bar[XB_TMO], 1u); break; } }
    }
    nloc = mine > 0u ? mine : 1u; nx = cnt > 0u ? cnt : 1u;
}

__device__ __forceinline__ void xcd_barrier(const XcdBarrier& b) {
    asm volatile("s_waitcnt vmcnt(0)" ::: "memory");
    __syncthreads();
    if (threadIdx.x == 0) {
        unsigned* bar = b.bar;
        __builtin_amdgcn_s_waitcnt(0);
        unsigned nloc = b.st[0], nx = b.st[1];
        if (nloc == 0u) { xcd_barrier_complete(bar, b.x, nloc, nx); b.st[0] = nloc; b.st[1] = nx; }
        const unsigned old = xb_add(&bar[XB_XSUB(b.x)], 1u);
        const unsigned gen = old / nloc;
        if (old + 1u == (gen + 1u) * nloc) {
            __builtin_amdgcn_fence(__ATOMIC_RELEASE, "agent");
            asm volatile("s_waitcnt vmcnt(0)" ::: "memory");
            const unsigned og = xb_add(&bar[XB_TOP], 1u);
            const unsigned tg = og / nx;
            if (og + 1u == (tg + 1u) * nx) xb_add(&bar[XB_TOPGEN], 1u);
            else XB_SPIN(xb_ld(&bar[XB_TOPGEN]) == tg, bar);
            __builtin_amdgcn_fence(__ATOMIC_ACQUIRE, "agent");
            xb_add(&bar[XB_XGEN(b.x)], 1u);
            asm volatile("s_waitcnt vmcnt(0)" ::: "memory");
        } else {
            XB_SPIN(xb_ld(&bar[XB_XGEN(b.x)]) == gen, bar);
            __builtin_amdgcn_fence(__ATOMIC_ACQUIRE, "agent");
            asm volatile("s_waitcnt vmcnt(0)" ::: "memory");
        }
    }
    __syncthreads();
}

constexpr int NWAVES = 8;
#ifndef MK_N_LAUNCHES
#define MK_N_LAUNCHES 1
#endif
constexpr int N_PHASES = 8;
#ifndef PROBE_DUP
#define PROBE_DUP (-1)
#endif
constexpr int N_LAUNCHES = MK_N_LAUNCHES;
constexpr int D = 1024, LSEQ = 2064  , NPR = 8 * LSEQ  , NSR = 512  , M = NPR + NSR  , MP = 17152  ;
constexpr int DIN = 1280, DFF = 4096, DPOOL = 512, QOFF = 512, KOFF = 1024, VOFF = 1152;
constexpr float LN_EPS = 1e-5f, LOG2E = 1.4426950408889634f;
constexpr size_t O_YP = 0, O_YS = 16777216, O_KP = 17301504, O_VP = 17432576, O_PP = 17563648, O_KS = 17625088, O_VS = 19722240, O_PS = 21819392;
constexpr size_t MiB = 1u << 20;
constexpr size_t WS_CTL = 0, CTL_ZERO_BYTES = 1 * MiB;
constexpr size_t WS_WIN = 1 * MiB, WS_WOUT = 4 * MiB, WS_W1 = 6 * MiB, WS_W2 = 14 * MiB, WS_WPOOL = 22 * MiB;
constexpr size_t WS_KC = 23 * MiB, WS_VC = 27 * MiB, WS_SPB = 31 * MiB;
constexpr size_t WS_R1 = 33 * MiB, WS_H1 = 67 * MiB;
constexpr size_t WS_H0 = 101 * MiB, WS_PROJ = 135 * MiB, WS_MIX = 177 * MiB;
constexpr size_t WS_ACT = 101 * MiB;
constexpr size_t WS_END = 235 * MiB;
static_assert(WS_WIN + (size_t)DIN * D * 2 <= WS_WOUT && WS_WPOOL + 4 * 128 * 128 * 2 <= WS_KC && WS_SPB + 2 * MiB <= WS_R1 && WS_R1 + (size_t)MP * D * 2 <= WS_H1 && WS_H1 + (size_t)MP * D * 2 <= WS_H0 &&
              WS_H0 + (size_t)MP * D * 2 <= WS_PROJ && WS_PROJ + (size_t)MP * DIN * 2 <= WS_MIX && WS_MIX + (size_t)MP * D * 2 <= WS_END && WS_ACT + (size_t)MP * DFF * 2 <= WS_END, "d_ws map");
constexpr int CW_BAR = 4096;
constexpr int RING_BYTES = 131072;
constexpr int LDSCTL_OFF = RING_BYTES, MISC_OFF = LDSCTL_OFF + 320;
constexpr int LDS_BYTES = 147456;
constexpr int TAB_OFF = LDSCTL_OFF + 1024;

struct Args { const float* in[20]; float* out; unsigned char* ws; int ph_lo, ph_hi; };
struct Frame {
    LAS unsigned char* lds;
    volatile LAS unsigned* MISC;
    gu32* ctl;
    int tid, lane, wave, vcu, G;
};
#define T_XP(A) ((A).in[0])
#define T_XS(A) ((A).in[1])
#define T_CK(A) ((A).in[2])
#define T_CV(A) ((A).in[3])
#define T_SPOOL(A) ((A).in[4])
#define T_META(A) ((A).in[5])
#define T_EG(A) ((A).in[6])
#define T_EB(A) ((A).in[7])
#define T_REL(A) ((A).in[8])
#define T_WIN(A) ((A).in[9])
#define T_WPOOL(A) ((A).in[10])
#define T_PSCALE(A) ((A).in[11])
#define T_SINKS(A) ((A).in[12])
#define T_WOUT(A) ((A).in[13])
#define T_G1(A) ((A).in[14])
#define T_B1(A) ((A).in[15])
#define T_W1(A) ((A).in[16])
#define T_W2(A) ((A).in[17])
#define T_G2(A) ((A).in[18])
#define T_B2(A) ((A).in[19])
#define W_(A, off) ((bf16*)((A).ws + (off)))

__device__ __forceinline__ v4u mixer_ldcvt8(const float* p) { const f32x4 a = *(const GAS f32x4*)p, b = *(const GAS f32x4*)(p + 4); v4u w; w.x = pk2(a.x, a.y); w.y = pk2(a.z, a.w); w.z = pk2(b.x, b.y); w.w = pk2(b.z, b.w); return w; }
__device__ __forceinline__ float wave_sum(float v) {
#pragma unroll
    for (int o = 1; o < 64; o <<= 1) v += __shfl_xor(v, o);
    return v;
}
__device__ __forceinline__ void p0_transpose_item(const float* W, int K, int N, bf16* WT, LAS float* scr, int item, int lane, const float* nscale = nullptr) {
    const int nblk = N / 32, kb = item / nblk, nb = item % nblk, k0 = 64 * kb, n0 = 32 * nb;
    const float sc = nscale ? nscale[n0 + (lane & 31)] : 1.0f;
#pragma unroll 16
    for (int i = 0; i < 32; ++i) { const int kk = 2 * i + (lane >> 5); scr[kk * 33 + (lane & 31)] = W[(size_t)(k0 + kk) * N + n0 + (lane & 31)] * sc; }
    LDS_WAIT(); asm volatile("" ::: "memory");
    const int c = lane & 7;
#pragma unroll
    for (int j = 0; j < 4; ++j) { const int n = (lane >> 3) + 8 * j; const LAS float* s = scr + (8 * c) * 33 + n;
        v4u o; o.x = pk2(s[0 * 33], s[1 * 33]); o.y = pk2(s[2 * 33], s[3 * 33]); o.z = pk2(s[4 * 33], s[5 * 33]); o.w = pk2(s[6 * 33], s[7 * 33]);
        *(GAS v4u*)(WT + (size_t)(n0 + n) * K + k0 + 8 * c) = o; }
    LDS_WAIT(); asm volatile("" ::: "memory");
}
__device__ __forceinline__ void ln_f32row_to_bf16(const float* xrow, bf16* orow, const float* g, const float* b, int lane) {
    const GAS f32x4* xr = (const GAS f32x4*)xrow + lane;
    f32x4 v[4]; float s = 0.f;
#pragma unroll
    for (int j = 0; j < 4; ++j) { v[j] = xr[64 * j]; s += (v[j].x + v[j].y) + (v[j].z + v[j].w); }
    const float mean = wave_sum(s) * (1.f / D); float s2 = 0.f;
#pragma unroll
    for (int j = 0; j < 4; ++j) { v[j] = v[j] - mean; s2 += (v[j].x * v[j].x + v[j].y * v[j].y) + (v[j].z * v[j].z + v[j].w * v[j].w); }
    const float rstd = 1.f / sqrtf(wave_sum(s2) * (1.f / D) + LN_EPS);
    GAS unsigned long long* o8 = (GAS unsigned long long*)orow + lane;
#pragma unroll
    for (int j = 0; j < 4; ++j) { const f32x4 gv = ((const GAS f32x4*)g)[lane + 64 * j], bv = ((const GAS f32x4*)b)[lane + 64 * j]; const f32x4 o = v[j] * rstd * gv + bv;
        o8[64 * j] = (unsigned long long)pk2(o.x, o.y) | ((unsigned long long)pk2(o.z, o.w) << 32); }
}
__device__ __forceinline__ void ln_bf16row_to_bf16(const bf16* xrow, bf16* orow, const float* g, const float* b, int lane) {
    float x[16]; float s = 0.f;
#pragma unroll
    for (int jj = 0; jj < 2; ++jj) { const v4u w = ((const GAS v4u*)xrow)[lane + 64 * jj];
        x[8 * jj + 0] = pg8::bf_lo(w.x); x[8 * jj + 1] = pg8::bf_hi(w.x); x[8 * jj + 2] = pg8::bf_lo(w.y); x[8 * jj + 3] = pg8::bf_hi(w.y);
        x[8 * jj + 4] = pg8::bf_lo(w.z); x[8 * jj + 5] = pg8::bf_hi(w.z); x[8 * jj + 6] = pg8::bf_lo(w.w); x[8 * jj + 7] = pg8::bf_hi(w.w); }
#pragma unroll
    for (int e = 0; e < 16; ++e) s += x[e];
    const float mean = wave_sum(s) * (1.f / D); float s2 = 0.f;
#pragma unroll
    for (int e = 0; e < 16; ++e) { x[e] -= mean; s2 += x[e] * x[e]; }
    const float rstd = 1.f / sqrtf(wave_sum(s2) * (1.f / D) + LN_EPS);
#pragma unroll
    for (int jj = 0; jj < 2; ++jj) { const int base = 512 * jj + 8 * lane;
        const f32x4 g0 = *(const GAS f32x4*)(g + base), g1v = *(const GAS f32x4*)(g + base + 4), b0 = *(const GAS f32x4*)(b + base), b1v = *(const GAS f32x4*)(b + base + 4);
        v4u o; o.x = pk2(x[8 * jj + 0] * rstd * g0.x + b0.x, x[8 * jj + 1] * rstd * g0.y + b0.y); o.y = pk2(x[8 * jj + 2] * rstd * g0.z + b0.z, x[8 * jj + 3] * rstd * g0.w + b0.w);
        o.z = pk2(x[8 * jj + 4] * rstd * g1v.x + b1v.x, x[8 * jj + 5] * rstd * g1v.y + b1v.y); o.w = pk2(x[8 * jj + 6] * rstd * g1v.z + b1v.z, x[8 * jj + 7] * rstd * g1v.w + b1v.w);
        ((GAS v4u*)orow)[lane + 64 * jj] = o; }
}
__device__ __forceinline__ void ln_f32row_inplace(float* row, const float* g, const float* b, int lane) {
    GAS f32x4* xr = (GAS f32x4*)row + lane;
    f32x4 v[4]; float s = 0.f;
#pragma unroll
    for (int j = 0; j < 4; ++j) { v[j] = xr[64 * j]; s += (v[j].x + v[j].y) + (v[j].z + v[j].w); }
    const float mean = wave_sum(s) * (1.f / D); float s2 = 0.f;
#pragma unroll
    for (int j = 0; j < 4; ++j) { v[j] = v[j] - mean; s2 += (v[j].x * v[j].x + v[j].y * v[j].y) + (v[j].z * v[j].z + v[j].w * v[j].w); }
    const float rstd = 1.f / sqrtf(wave_sum(s2) * (1.f / D) + LN_EPS);
#pragma unroll
    for (int j = 0; j < 4; ++j) { const f32x4 gv = ((const GAS f32x4*)g)[lane + 64 * j], bv = ((const GAS f32x4*)b)[lane + 64 * j]; xr[64 * j] = v[j] * rstd * gv + bv; }
}

__device__ __forceinline__ void p0_prologue(const Frame& F, const Args& A) {
    LAS float* scr = (LAS float*)(F.lds + F.wave * 16384);
    const int gw = F.vcu * NWAVES + F.wave, NGW = F.G * NWAVES;
    constexpr int I_IN = (D / 64) * (DIN / 32), I_OUT = (D / 64) * (D / 32), I_1 = (D / 64) * (DFF / 32), I_2 = (DFF / 64) * (D / 32), I_P = (128 / 64) * (128 / 32);
    constexpr int NITEMS = I_IN + I_OUT + I_1 + I_2;
    for (int it = gw; it < NITEMS; it += NGW) {
        int r = it;
        if (r < I_1) { p0_transpose_item(T_W1(A), D, DFF, W_(A, WS_W1), scr, r, F.lane); continue; } r -= I_1;
        if (r < I_2) { p0_transpose_item(T_W2(A), DFF, D, W_(A, WS_W2), scr, r, F.lane); continue; } r -= I_2;
        if (r < I_IN) { p0_transpose_item(T_WIN(A), D, DIN, W_(A, WS_WIN), scr, r, F.lane); continue; } r -= I_IN;
        p0_transpose_item(T_WOUT(A), D, D, W_(A, WS_WOUT), scr, r, F.lane);
    }
    for (int fi = gw * 64 + F.lane; fi < 4 * 4 * 8 * 64; fi += NGW * 64) { const int ln = fi & 63, st = (fi >> 6) & 7, nb = (fi >> 9) & 3, g = fi >> 11, d = 32 * nb + (ln & 31), cbase = 16 * st + 4 * (ln >> 5);
        const float* wsrc = T_WPOOL(A) + (size_t)g * 128 * 128 + d; const float sc = T_PSCALE(A)[g * 128 + d]; float v[8];
#pragma unroll
        for (int j = 0; j < 8; ++j) v[j] = wsrc[(size_t)(cbase + 8 * (j >> 2) + (j & 3)) * 128] * sc;
        v4u o; o.x = pk2(v[0], v[1]); o.y = pk2(v[2], v[3]); o.z = pk2(v[4], v[5]); o.w = pk2(v[6], v[7]);
        *(GAS v4u*)(W_(A, WS_WPOOL) + (size_t)fi * 8) = o;
    }
    for (int m = gw; m < MP; m += NGW) {
        bf16* orow = W_(A, WS_H0) + (size_t)m * D;
        if (m < M) { const float* src;
            if (m < NPR) { const int b = m / LSEQ, t = m - b * LSEQ; src = t < 16 ? T_META(A) + (size_t)t * D : T_XP(A) + ((size_t)b * 2048 + (t - 16)) * D; }
            else src = T_XS(A) + (size_t)(m - NPR) * D;
            ln_f32row_to_bf16(src, orow, T_EG(A), T_EB(A), F.lane); }
        else { const v4u z = {0u, 0u, 0u, 0u}; ((GAS v4u*)orow)[F.lane] = z; ((GAS v4u*)orow)[F.lane + 64] = z; ((GAS v4u*)(W_(A, WS_MIX) + (size_t)m * D))[F.lane] = z; ((GAS v4u*)(W_(A, WS_MIX) + (size_t)m * D))[F.lane + 64] = z; }
    }
    const int gt = gw * 64 + F.lane, NGT = NGW * 64;
    constexpr int NKV4 = 128 * 124 * 128 / 4, NP4 = 128 * 11 * 512 / 4;
#pragma unroll 4
    for (int i = gt; i < 2 * NKV4 + NP4; i += NGT) {
        if (i < 2 * NKV4) { const int which = i >= NKV4, j = which ? i - NKV4 : i; const int db = j / (124 * 32), rem = j - db * (124 * 32);
            const float* src = (which ? T_CV(A) : T_CK(A)) + (size_t)db * 128 * 128 + 4 * 128 + (size_t)rem * 4; float* dst = A.out + (which ? O_VS : O_KS) + (size_t)db * 128 * 128 + (size_t)rem * 4;
            *(GAS f32x4*)dst = *(const GAS f32x4*)src; }
        else { const int j = i - 2 * NKV4; const int db = j / (11 * 128), rem = j - db * (11 * 128);
            *(GAS f32x4*)(A.out + O_PS + (size_t)db * 15 * 512 + (size_t)rem * 4) = *(const GAS f32x4*)(T_SPOOL(A) + (size_t)db * 15 * 512 + 4 * 512 + (size_t)rem * 4); }
    }
    constexpr int NC8 = 128 * 128 * 128 / 8;
#pragma unroll 4
    for (int i = gt; i < 2 * NC8; i += NGT) { const int which = i >= NC8, j = which ? i - NC8 : i;
        *(GAS v4u*)(W_(A, which ? WS_VC : WS_KC) + (size_t)j * 8) = mixer_ldcvt8((which ? T_CV(A) : T_CK(A)) + (size_t)j * 8); }
    constexpr int NS8 = 128 * 15 * 512 / 8;
    for (int i = gt; i < NS8; i += NGT) *(GAS v4u*)(W_(A, WS_SPB) + (size_t)i * 8) = mixer_ldcvt8(T_SPOOL(A) + (size_t)i * 8);
}

namespace mixer {
typedef short bf16x8 __attribute__((ext_vector_type(8)));
typedef short s16x4 __attribute__((ext_vector_type(4)));
typedef float f32x16 __attribute__((ext_vector_type(16)));
typedef unsigned u32x2 __attribute__((ext_vector_type(2)));
typedef float f32x2_t __attribute__((ext_vector_type(2))); typedef __bf16 bf16x2_t __attribute__((ext_vector_type(2)));
typedef short v4i16_t __attribute__((ext_vector_type(4)));
__device__ __forceinline__ unsigned cvtpk(float lo, float hi) { f32x2_t v = {lo, hi}; bf16x2_t b = __builtin_convertvector(v, bf16x2_t); return __builtin_bit_cast(unsigned, b); }
__device__ __forceinline__ float bflo(unsigned x) { return __uint_as_float(x << 16); }
__device__ __forceinline__ float bfhi(unsigned x) { return __uint_as_float(x & 0xffff0000u); }
__device__ __forceinline__ v4u ldcvt8(const float* p) { const f32x4 a = *(const GAS f32x4*)p, b = *(const GAS f32x4*)(p + 4);
    v4u w; w.x = cvtpk(a.x, a.y); w.y = cvtpk(a.z, a.w); w.z = cvtpk(b.x, b.y); w.w = cvtpk(b.z, b.w); return w; }
__device__ __forceinline__ s16x4 vtr(const LAS unsigned char* p) { return __builtin_bit_cast(s16x4, __builtin_amdgcn_ds_read_tr16_b64_v4i16((LAS v4i16_t*)p)); }
__device__ __forceinline__ float swapmax(float m) { auto rr = __builtin_amdgcn_permlane32_swap(__float_as_uint(m), __float_as_uint(m), false, false); return fmaxf(__uint_as_float(rr[0]), __uint_as_float(rr[1])); }
__device__ __forceinline__ float swapadd(float m) { auto rr = __builtin_amdgcn_permlane32_swap(__float_as_uint(m), __float_as_uint(m), false, false); return __uint_as_float(rr[0]) + __uint_as_float(rr[1]); }
__device__ __forceinline__ int rel_bucket(int n) { if (n < 16) return n; const int l = 16 + (int)(logf((float)n / 16.f) / 2.0794415416798357f * 16.f); return l < 31 ? l : 31; }
__device__ __forceinline__ void dma16(const void* gsrc, LAS unsigned char* ldst) { __builtin_amdgcn_global_load_lds((const unsigned*)gsrc, (LAS unsigned*)ldst, 16, 0, 0); }
#define F32X16_ZERO (f32x16){0.f, 0.f, 0.f, 0.f, 0.f, 0.f, 0.f, 0.f, 0.f, 0.f, 0.f, 0.f, 0.f, 0.f, 0.f, 0.f}

template <bool SAMPLE> __device__ __forceinline__ const bf16* kv_row(const Args& A, int a0, int hk, int i, int r, int off, size_t cache_off) {
    if (!SAMPLE) { int kr = a0 * 32 - 128 + 32 * i + r; kr = kr < 0 ? 0 : kr; return W_(A, WS_PROJ) + (size_t)kr * DIN + off + hk * 64; }
    else if (i < 4) return W_(A, cache_off) + ((size_t)a0 * 128 + 32 * i + r) * 128 + hk * 64;
    else return W_(A, WS_PROJ) + (size_t)(NPR + a0 * 4 + (r & 3)) * DIN + off + hk * 64;
}

template <bool SAMPLE>
__device__ __forceinline__ void attn_unit(const Frame& F, const Args& A, int a0, int a1, LAS unsigned char* vst, const LAS float* tab) {
    const int lane = F.lane, q = lane & 31, hi = lane >> 5;
    int h, hk, qrow, dmax, ts;
    if (!SAMPLE) { h = a1; hk = h >> 2; qrow = a0 * 32 + q; const int tq = qrow % LSEQ; dmax = tq < 127 ? tq : 127; ts = q; }
    else { hk = a1; const int qq = q & 15; h = hk * 4 + (qq >> 2); ts = qq & 3; qrow = NPR + a0 * 4 + ts; dmax = 127; }
    const bf16* qp = W_(A, WS_PROJ) + (size_t)qrow * DIN + QOFF + h * 64 + hi * 8;
    bf16x8 qr[4], kf[5][4];
#pragma unroll
    for (int d0 = 0; d0 < 4; ++d0) qr[d0] = *(const GAS bf16x8*)(qp + d0 * 16);
#pragma unroll
    for (int i = 0; i < 5; ++i) { const bf16* kp = kv_row<SAMPLE>(A, a0, hk, i, q, KOFF, WS_KC) + hi * 8;
#pragma unroll
        for (int d0 = 0; d0 < 4; ++d0) kf[i][d0] = *(const GAS bf16x8*)(kp + d0 * 16); }
    f32x16 S[5];
#pragma unroll
    for (int i = 0; i < 5; ++i) {
#pragma unroll
        for (int d0 = 0; d0 < 4; ++d0) S[i] = d0 == 0 ? __builtin_amdgcn_mfma_f32_32x32x16_bf16(kf[i][d0], qr[d0], F32X16_ZERO, 0, 0, 0) : __builtin_amdgcn_mfma_f32_32x32x16_bf16(kf[i][d0], qr[d0], S[i], 0, 0, 0); }
    __builtin_amdgcn_sched_barrier(0);
#define ATT_DMA_V(i, buf) do { _Pragma("unroll") for (int pc = 0; pc < 4; ++pc) { const int dh = pc >> 1, rg = pc & 1; \
        dma16(kv_row<SAMPLE>(A, a0, hk, (i), 16 * rg + (lane >> 2), VOFF, WS_VC) + dh * 32 + (lane & 3) * 8, vst + (buf) * 4096 + pc * 1024); } } while (0)
    ATT_DMA_V(0, 0); ATT_DMA_V(1, 1); ATT_DMA_V(2, 2); ATT_DMA_V(3, 3);
    const float SC = 0.125f * LOG2E;
    const int dl = ts + 128 - 4 * hi;
    const LAS float* tp = tab + h * 192 + (31 - ts + 4 * hi);
    float mx = -INFINITY;
#pragma unroll
    for (int i = 0; i < 5; ++i)
#pragma unroll
        for (int r = 0; r < 16; ++r) { const int c = 32 * i + (r & 3) + 8 * (r >> 2); const int dist = dl - c; const bool ok = (unsigned)dist <= (unsigned)dmax;
            const float bb = tp[c];
            const float sv = fmaf(S[i][r], SC, bb); const float s = ok ? sv : -INFINITY; S[i][r] = s; mx = fmaxf(mx, s); }
    mx = swapmax(mx);
    const float sk = T_SINKS(A)[h] * LOG2E; mx = fmaxf(mx, sk);
    float sum = 0.f;
    v4u pw[5][2];
#pragma unroll
    for (int i = 0; i < 5; ++i)
#pragma unroll
        for (int s2 = 0; s2 < 2; ++s2) { float p[8];
#pragma unroll
            for (int j = 0; j < 8; ++j) { p[j] = __builtin_amdgcn_exp2f(S[i][8 * s2 + j] - mx); sum += p[j]; }
            pw[i][s2].x = cvtpk(p[0], p[1]); pw[i][s2].y = cvtpk(p[2], p[3]); pw[i][s2].z = cvtpk(p[4], p[5]); pw[i][s2].w = cvtpk(p[6], p[7]); }
    sum = swapadd(sum);
    const float inv = 1.0f / (sum + __builtin_amdgcn_exp2f(sk - mx));
    f32x16 o[2];
    const int vro = ((lane >> 4) & 1) * 32 + (lane & 3) * 8 + (4 * hi + ((lane & 15) >> 2)) * 64;
    asm volatile("s_waitcnt vmcnt(0)" ::: "memory");
#pragma unroll
    for (int ii = 0; ii < 5; ++ii) {
        const int i = ii; LAS unsigned char* vb = vst + (i & 3) * 4096;
        if (i == 4) asm volatile("s_waitcnt vmcnt(0)" ::: "memory");
#pragma unroll
        for (int s2 = 0; s2 < 2; ++s2) {
            const bf16x8 pf = __builtin_bit_cast(bf16x8, pw[i][s2]);
#pragma unroll
            for (int d0 = 0; d0 < 2; ++d0) { const s16x4 lo = vtr(vb + vro + d0 * 2048 + s2 * 1024), hh = vtr(vb + vro + d0 * 2048 + s2 * 1024 + 512);
                const bf16x8 vf = (bf16x8){lo[0], lo[1], lo[2], lo[3], hh[0], hh[1], hh[2], hh[3]};
                o[d0] = (i == 0 && s2 == 0) ? __builtin_amdgcn_mfma_f32_32x32x16_bf16(vf, pf, F32X16_ZERO, 0, 0, 0) : __builtin_amdgcn_mfma_f32_32x32x16_bf16(vf, pf, o[d0], 0, 0, 0); }
        }
        if (i == 0) { asm volatile("s_waitcnt lgkmcnt(0)" ::: "memory"); ATT_DMA_V(4, 0); }
    }
#undef ATT_DMA_V
    if (!SAMPLE || q < 16) { bf16* op = W_(A, WS_MIX) + (size_t)qrow * D + DPOOL + h * 64 + 4 * hi;
#pragma unroll
        for (int d0 = 0; d0 < 2; ++d0)
#pragma unroll
            for (int g4 = 0; g4 < 4; ++g4) { u32x2 w; w.x = cvtpk(o[d0][4 * g4] * inv, o[d0][4 * g4 + 1] * inv); w.y = cvtpk(o[d0][4 * g4 + 2] * inv, o[d0][4 * g4 + 3] * inv);
                *(GAS u32x2*)(op + d0 * 32 + 8 * g4) = w; } }
}

template <bool SAMPLE>
__device__ __forceinline__ void pool_unit(const Frame& F, const Args& A, int blk, int g, LAS unsigned char* ust) {
    const int lane = F.lane, q = lane & 31, hi = lane >> 5, w = 2 << g;
    int n, trow, qrow;
    if (!SAMPLE) { qrow = blk * 32 + q; const int tq = qrow % LSEQ; n = (tq + 1) < w ? (tq + 1) : w; trow = q + 16; }
    else { const int t = q & 7, dbl = t >> 2, sx = t & 3; n = q < 8 ? w : 0; trow = 19 * dbl + 15 + sx; qrow = NPR + blk * 8 + t; }
#pragma unroll
    for (int rg = 0; rg < 3; ++rg) { const int rr = 16 * rg + (lane >> 2); const bf16* src;
        if (!SAMPLE) { int gr = blk * 32 - 16 + rr; gr = gr < 0 ? 0 : gr; src = W_(A, WS_PROJ) + (size_t)gr * DIN; }
        else { const int dbl = rr >= 19 ? 1 : 0, idx = rr - 19 * dbl, db = blk * 2 + dbl;
            src = (idx < 15) ? W_(A, WS_SPB) + ((size_t)db * 15 + idx) * 512 : W_(A, WS_PROJ) + (size_t)(NPR + db * 4 + ((idx - 15) & 3)) * DIN; }
        src += g * 128 + (lane & 3) * 8;
#pragma unroll
        for (int cb = 0; cb < 4; ++cb) dma16(src + 32 * cb, ust + (cb * 3 + rg) * 1024); }
    bf16x8 band[3];
#pragma unroll
    for (int s = 0; s < 3; ++s) { float c[8];
#pragma unroll
        for (int j = 0; j < 8; ++j) { const int rr = 16 * s + 8 * (j >> 2) + 4 * hi + (j & 3); const bool in = rr <= trow && rr > trow - n; c[j] = in ? (rr == trow ? 1.f - (float)n : 1.f) : 0.f; }
        v4u bw; bw.x = cvtpk(c[0], c[1]); bw.y = cvtpk(c[2], c[3]); bw.z = cvtpk(c[4], c[5]); bw.w = cvtpk(c[6], c[7]); band[s] = __builtin_bit_cast(bf16x8, bw); }
    const int uro = ((lane >> 4) & 1) * 32 + (lane & 3) * 8 + (4 * hi + ((lane & 15) >> 2)) * 64;
    asm volatile("s_waitcnt vmcnt(0)" ::: "memory");
    f32x16 np[4];
#pragma unroll
    for (int cb = 0; cb < 4; ++cb) {
#pragma unroll
        for (int s = 0; s < 3; ++s) { const s16x4 lo = vtr(ust + uro + (cb * 3 + s) * 1024), hh = vtr(ust + uro + (cb * 3 + s) * 1024 + 512);
            const bf16x8 uf = (bf16x8){lo[0], lo[1], lo[2], lo[3], hh[0], hh[1], hh[2], hh[3]};
            np[cb] = s == 0 ? __builtin_amdgcn_mfma_f32_32x32x16_bf16(uf, band[s], F32X16_ZERO, 0, 0, 0) : __builtin_amdgcn_mfma_f32_32x32x16_bf16(uf, band[s], np[cb], 0, 0, 0); } }
    f32x16 z[4];
    const bf16* wp = W_(A, WS_WPOOL) + ((size_t)g * 4 * 8 * 64 + lane) * 8;
    v4u wc[4], wn[4];
#pragma unroll
    for (int nb = 0; nb < 4; ++nb) wc[nb] = *(const GAS v4u*)(wp + (size_t)(nb * 8) * 512);
#pragma unroll
    for (int st = 0; st < 8; ++st) { const int cb = st >> 1, s2 = st & 1;
        if (st + 1 < 8) {
#pragma unroll
            for (int nb = 0; nb < 4; ++nb) wn[nb] = *(const GAS v4u*)(wp + (size_t)(nb * 8 + st + 1) * 512); }
        v4u pw; pw.x = cvtpk(np[cb][8 * s2 + 0], np[cb][8 * s2 + 1]); pw.y = cvtpk(np[cb][8 * s2 + 2], np[cb][8 * s2 + 3]); pw.z = cvtpk(np[cb][8 * s2 + 4], np[cb][8 * s2 + 5]); pw.w = cvtpk(np[cb][8 * s2 + 6], np[cb][8 * s2 + 7]);
        const bf16x8 pf = __builtin_bit_cast(bf16x8, pw);
#pragma unroll
        for (int nb = 0; nb < 4; ++nb)
            z[nb] = st == 0 ? __builtin_amdgcn_mfma_f32_32x32x16_bf16(__builtin_bit_cast(bf16x8, wc[nb]), pf, F32X16_ZERO, 0, 0, 0) : __builtin_amdgcn_mfma_f32_32x32x16_bf16(__builtin_bit_cast(bf16x8, wc[nb]), pf, z[nb], 0, 0, 0);
#pragma unroll
        for (int nb = 0; nb < 4; ++nb) wc[nb] = wn[nb];
    }
    if (n > 0) { const float rc = 1.0f / (float)n; bf16* op = W_(A, WS_MIX) + (size_t)qrow * D + g * 128 + 4 * hi;
#pragma unroll
        for (int nb = 0; nb < 4; ++nb)
#pragma unroll
            for (int g4 = 0; g4 < 4; ++g4) { u32x2 wv; wv.x = cvtpk(z[nb][4 * g4] * rc, z[nb][4 * g4 + 1] * rc); wv.y = cvtpk(z[nb][4 * g4 + 2] * rc, z[nb][4 * g4 + 3] * rc);
                *(GAS u32x2*)(op + nb * 32 + 8 * g4) = wv; } }
}
}

__device__ __forceinline__ void p2_mixers(const Frame& F, const Args& A) {
    LAS float* tab = (LAS float*)(F.lds + TAB_OFF);
    for (int e = F.tid; e < 8 * 192; e += NWAVES * 64) { const int h = e / 192, x = e - h * 192, dist = 159 - x; float v = 0.f;
        if (dist >= 0 && dist < 128) v = T_REL(A)[mixer::rel_bucket(dist) * 8 + h] * LOG2E; tab[e] = v; }
    __syncthreads();
    LAS unsigned char* wst = F.lds + F.wave * 16384;
    const int gw = F.vcu * NWAVES + F.wave, NGW = F.G * NWAVES;
    constexpr int NA = (NPR / 32) * 8, NB = 128 * 2, NC = (NPR / 32) * 4, ND = 64 * 4, NU = NA + NB + NC + ND;
#define FIRST_U(lo) ((lo) <= gw ? gw : gw + (((lo) - gw + NGW - 1) / NGW) * NGW)
#ifndef PROBE_P2
#define PROBE_P2 0
#endif
    for (int rep = 0; rep < ((PROBE_P2 & 1) ? A.ph_hi - 6 : 1); ++rep)
    for (int u = gw; u < NA; u += NGW) mixer::attn_unit<false>(F, A, u >> 3, u & 7, wst, tab);
    for (int u = FIRST_U(NA); u < NA + NB; u += NGW) { const int v = u - NA; mixer::attn_unit<true>(F, A, v >> 1, v & 1, wst, tab); }
    for (int rep = 0; rep < ((PROBE_P2 & 2) ? A.ph_hi - 6 : 1); ++rep)
    for (int u = FIRST_U(NA + NB); u < NA + NB + NC; u += NGW) { const int v = u - NA - NB; mixer::pool_unit<false>(F, A, v >> 2, v & 3, wst); }
    for (int u = FIRST_U(NA + NB + NC); u < NU; u += NGW) { const int v = u - NA - NB - NC; mixer::pool_unit<true>(F, A, v >> 2, v & 3, wst); }
#undef FIRST_U
    const int gt = gw * 64 + F.lane, NGT = NGW * 64;
    constexpr int N1 = 8 * 128 * 128 / 8, N2 = 8 * 15 * 512 / 8, N3 = 128 * 4 * 128 / 8, N4 = 128 * 4 * 512 / 8, NT = 2 * N1 + N2 + 2 * N3 + N4;
    for (int i = gt; i < NT; i += NGT) {
        const bf16* src; float* dst; int j = i;
        if (j < 2 * N1) { const int which = j >= N1; j -= which * N1; const int b = j / (128 * 16), rem = j - b * (128 * 16), r = rem >> 4, c8 = rem & 15;
            src = W_(A, WS_PROJ) + (size_t)(b * LSEQ + (LSEQ - 128) + r) * DIN + (which ? VOFF : KOFF) + c8 * 8; dst = A.out + (which ? O_VP : O_KP) + (size_t)j * 8; }
        else if ((j -= 2 * N1) < N2) { const int b = j / (15 * 64), rem = j - b * (15 * 64), r = rem >> 6, c8 = rem & 63;
            src = W_(A, WS_PROJ) + (size_t)(b * LSEQ + (LSEQ - 15) + r) * DIN + c8 * 8; dst = A.out + O_PP + (size_t)j * 8; }
        else if ((j -= N2) < 2 * N3) { const int which = j >= N3; j -= which * N3; const int db = j / (4 * 16), rem = j - db * (4 * 16), s = rem >> 4, c8 = rem & 15;
            src = W_(A, WS_PROJ) + (size_t)(NPR + db * 4 + s) * DIN + (which ? VOFF : KOFF) + c8 * 8; dst = A.out + (which ? O_VS : O_KS) + ((size_t)db * 128 + 124 + s) * 128 + c8 * 8; }
        else { j -= 2 * N3; const int db = j / (4 * 64), rem = j - db * (4 * 64), s = rem >> 6, c8 = rem & 63;
            src = W_(A, WS_PROJ) + (size_t)(NPR + db * 4 + s) * DIN + c8 * 8; dst = A.out + O_PS + ((size_t)db * 15 + 11 + s) * 512 + c8 * 8; }
        const v4u x = *(const GAS v4u*)src;
        f32x4 a = {mixer::bflo(x.x), mixer::bfhi(x.x), mixer::bflo(x.y), mixer::bfhi(x.y)}, b = {mixer::bflo(x.z), mixer::bfhi(x.z), mixer::bflo(x.w), mixer::bfhi(x.w)};
        *(GAS f32x4*)dst = a; *(GAS f32x4*)(dst + 4) = b;
    }
}

__global__ void __launch_bounds__(NWAVES * 64, 2) hymba_fwd(Args args) {
    extern __shared__ __attribute__((aligned(16))) unsigned char lds[];
    Frame F;
    F.lds = (LAS unsigned char*)lds;
    F.MISC = (volatile LAS unsigned*)(F.lds + MISC_OFF);
    F.tid = threadIdx.x; F.lane = F.tid & 63; F.wave = __builtin_amdgcn_readfirstlane(F.tid >> 6);
    F.G = gridDim.x; { const int bx = blockIdx.x; F.vcu = (F.G % 8 == 0) ? (bx % 8) * (F.G / 8) + bx / 8 : bx; }
    F.ctl = (gu32*)(args.ws + WS_CTL);
    const Args& A = args;
    for (int u = F.tid; u < (LDS_BYTES - LDSCTL_OFF) / 4; u += NWAVES * 64) ((LAS unsigned*)(F.lds + LDSCTL_OFF))[u] = 0u;
    __syncthreads();
    unsigned* const barw = (unsigned*)(F.ctl + CW_BAR) + (args.ph_lo ? XCD_BAR_WORDS : 0);
    XcdBarrier bar; bar.bar = barw; bar.x = 0; bar.st = nullptr;
    if (N_LAUNCHES == 1 && args.ph_hi - args.ph_lo > 1) bar = xcd_barrier_post(barw, F.MISC + 8);
    const int lo = args.ph_lo, hi = args.ph_hi;
#define IN(k) (lo <= (k) && (k) < hi)
#define SEAM(k) do { if (IN(k) && IN((k) + 1)) xcd_barrier(bar); } while (0)
    const int gw = F.vcu * NWAVES + F.wave, NGW = F.G * NWAVES;

    if (IN(0)) { p0_prologue(F, A); } SEAM(0);
    if (IN(1)) { pg8::Gemm g{W_(A, WS_H0), W_(A, WS_WIN), MP, DIN, D}; pg8::StaticOrder S; S.init(MP, DIN, F.G, (int)blockIdx.x);
        pg8::EpiB<0> E{W_(A, WS_PROJ), DIN, nullptr, 0};
        pg8::gemm_phase<pg8::EpiB<0>, pg8::StaticOrder, true, true>(F.lds, g, S, E); } SEAM(1);
    if (IN(2)) { p2_mixers(F, A); } SEAM(2);
    if (IN(3)) { pg8::Gemm g{W_(A, WS_MIX), W_(A, WS_WOUT), MP, D, D}; pg8::StaticOrder S; S.init(MP, D, F.G, (int)blockIdx.x);
        pg8::EpiB<2> E{W_(A, WS_R1), D, W_(A, WS_H0), D};
        pg8::gemm_phase<pg8::EpiB<2>, pg8::StaticOrder, true, true>(F.lds, g, S, E); } SEAM(3);
    if (IN(4)) { for (int m = gw; m < MP; m += NGW) ln_bf16row_to_bf16(W_(A, WS_R1) + (size_t)m * D, W_(A, WS_H1) + (size_t)m * D, T_G1(A), T_B1(A), F.lane); } SEAM(4);
    if (IN(5)) { pg8::Gemm g{W_(A, WS_H1), W_(A, WS_W1), MP, DFF, D}; pg8::StaticOrder S; S.init(MP, DFF, F.G, (int)blockIdx.x);
        pg8::EpiB<1> E{W_(A, WS_ACT), DFF, nullptr, 0};
        pg8::gemm_phase<pg8::EpiB<1>, pg8::StaticOrder, true, true>(F.lds, g, S, E); } SEAM(5);
    if (IN(6)) { pg8::Gemm g{W_(A, WS_ACT), W_(A, WS_W2), MP, D, DFF}; pg8::StaticOrder S; S.init(MP, D, F.G, (int)blockIdx.x);
        pg8::EpiOut E{A.out, W_(A, WS_H1)};
        pg8::gemm_phase<pg8::EpiOut, pg8::StaticOrder, true, true>(F.lds, g, S, E); } SEAM(6);
    if (IN(7)) { for (int r = gw; r < 16384 + 512; r += NGW) ln_f32row_inplace(A.out + (size_t)r * D, T_G2(A), T_B2(A), F.lane); }
#undef IN
#undef SEAM
}

extern "C" void kernel_launch(void* const* d_in, const int* in_sizes, int n_in, void* d_out, int out_size, void* d_ws, size_t ws_size, hipStream_t stream) {
    static int grid = 0;
    if (grid == 0) {
        if (n_in != 20 || ws_size < WS_END) { fprintf(stderr, "kernel_launch: unexpected problem (n_in %d, ws %zu)\n", n_in, ws_size); grid = -1; return; }
        int dev = 0, cus = 0, per_cu = 0;
        if (hipGetDevice(&dev) != hipSuccess || hipDeviceGetAttribute(&cus, hipDeviceAttributeMultiprocessorCount, dev) != hipSuccess) { grid = -1; return; }
        if (hipFuncSetAttribute((const void*)hymba_fwd, hipFuncAttributeMaxDynamicSharedMemorySize, LDS_BYTES) != hipSuccess) { fprintf(stderr, "kernel_launch: hipFuncSetAttribute failed\n"); grid = -1; return; }
        if (hipOccupancyMaxActiveBlocksPerMultiprocessor(&per_cu, (const void*)hymba_fwd, NWAVES * 64, LDS_BYTES) != hipSuccess || per_cu < 1) { fprintf(stderr, "kernel_launch: occupancy query says %d workgroups per CU\n", per_cu); per_cu = 1; }
        (void)hipGetLastError();
        grid = cus;
    }
    if (grid < 0) return;
    if (hipMemsetAsync((char*)d_ws + WS_CTL, 0, CTL_ZERO_BYTES, stream) != hipSuccess) { fprintf(stderr, "kernel_launch: memset failed\n"); return; }
    Args a{};
    for (int i = 0; i < 20; ++i) a.in[i] = (const float*)d_in[i];
    a.out = (float*)d_out; a.ws = (unsigned char*)d_ws;
    constexpr int NL = (PROBE_DUP >= 0) ? 2 : N_LAUNCHES;
    for (int li = 0; li < NL; ++li) {
        if (PROBE_DUP >= 0) { a.ph_lo = li ? PROBE_DUP : 0; a.ph_hi = li ? N_PHASES : PROBE_DUP + 1; }
        else { a.ph_lo = (N_LAUNCHES == 1) ? 0 : li; a.ph_hi = (N_LAUNCHES == 1) ? N_PHASES : li + 1; }
        hipLaunchKernelGGL(hymba_fwd, dim3(grid), dim3(NWAVES * 64), LDS_BYTES, stream, a);
        const hipError_t le = hipPeekAtLastError();
        if (le != hipSuccess) { fprintf(stderr, "kernel_launch: launch %d failed: %s\n", li, hipGetErrorName(le)); break; }
    }
}
```
